# Optimizing an MI355X kernel written in HIP

```python
import jax, jax.numpy as jnp
from jax import lax
import numpy as np

D_MODEL = 2048
BATCH = 2
SEQ = 8192
DEPTH = 1

CHUNK = 64
D_MIX = D_MODEL
D_CONV = D_MIX // 2
CONV_GROUPS = 8
CONV_WIDTH = 3
D_GLA_V = D_MIX - D_CONV
GLA_HEADS = 4
GLA_DV = D_GLA_V // GLA_HEADS
GLA_DK = GLA_DV // 2
D_GLA_K = GLA_HEADS * GLA_DK
GATE_RANK = 16
GATE_NORMALIZER = 16.0
D_FF = 4 * D_MODEL
EPS = 1e-6
IN_SIZES = (D_CONV, D_CONV, D_CONV, D_GLA_K, D_GLA_K, D_GLA_V, D_GLA_V, GATE_RANK)
D_IN = sum(IN_SIZES)

kernel_name = "hymba_conv_gla_sqrelu_block"


def rmsnorm(x, g):
    xf = x.astype(jnp.float32)
    y = xf * lax.rsqrt(jnp.mean(xf * xf, axis=-1, keepdims=True) + EPS)
    return (y * g.astype(jnp.float32)).astype(x.dtype)


def group_rms(x, groups):
    xf = x.astype(jnp.float32).reshape(x.shape[:-1] + (groups, x.shape[-1] // groups))
    xf = xf * lax.rsqrt(jnp.mean(xf * xf, axis=-1, keepdims=True) + EPS)
    return xf.reshape(x.shape)


def short_conv_mixer(b_gate, c_gate, h, conv_w, conv_g):
    seq = h.shape[1]
    u = c_gate * h
    up = jnp.pad(u, ((0, 0), (CONV_WIDTH - 1, 0), (0, 0)))
    conv = sum(up[:, k:k + seq, :] * conv_w[:, k] for k in range(CONV_WIDTH))
    y = b_gate * conv
    return (group_rms(y, CONV_GROUPS) * conv_g.astype(jnp.float32)).astype(h.dtype)


def gla_chunk_causal(q, k, v, log_a):
    bsz, seq, nh, dk = q.shape
    dv = v.shape[-1]
    nc = seq // CHUNK
    f32 = jnp.float32
    q = q.astype(f32).reshape(bsz, nc, CHUNK, nh, dk) * (dk ** -0.5)
    k = k.astype(f32).reshape(bsz, nc, CHUNK, nh, dk)
    v = v.astype(f32).reshape(bsz, nc, CHUNK, nh, dv)
    la = log_a.astype(f32).reshape(bsz, nc, CHUNK, nh, dk)
    b_cum = jnp.cumsum(la, axis=2)
    b_end = b_cum[:, :, -1:]
    k_dec = k * jnp.exp(b_end - b_cum)
    kv = jnp.einsum('bnshk,bnshv->bnhkv', k_dec, v)
    decay = jnp.exp(b_end[:, :, 0])

    def step(state, xs):
        q_c, dec_c, kv_c = xs
        state = dec_c[..., None] * state + kv_c
        o_c = jnp.einsum('bthk,bhkv->bthv', q_c, state)
        return state, o_c

    s0 = jnp.zeros((bsz, nh, dk, dv), f32)
    xs = (jnp.moveaxis(q, 1, 0), jnp.moveaxis(decay, 1, 0), jnp.moveaxis(kv, 1, 0))
    _, o = lax.scan(step, s0, xs)
    return jnp.moveaxis(o, 0, 1).reshape(bsz, seq, nh, dv)


def setup_inputs(seed: int = 0) -> dict:
    key = jax.random.key(seed)
    ks = jax.random.split(key, 14)
    f32 = jnp.float32
    nrm = lambda k, shape, s: jax.random.normal(k, shape, f32) * s
    gain = lambda k, shape: 1.0 + 0.02 * jax.random.normal(k, shape, f32)
    return {
        "x": jax.random.normal(ks[0], (BATCH, SEQ, D_MODEL), f32),
        "norm1_g": gain(ks[1], (DEPTH, D_MODEL)),
        "w_in": nrm(ks[2], (DEPTH, D_MODEL, D_IN), D_MODEL ** -0.5),
        "w_gate_up": nrm(ks[3], (DEPTH, GATE_RANK, D_GLA_K), GATE_RANK ** -0.5),
        "b_gate": nrm(ks[4], (DEPTH, D_GLA_K), 0.1),
        "conv_w": nrm(ks[5], (DEPTH, D_CONV, CONV_WIDTH), CONV_WIDTH ** -0.5),
        "conv_norm_g": gain(ks[6], (DEPTH, D_CONV)),
        "gla_norm_g": gain(ks[7], (DEPTH, GLA_DV)),
        "w_out": nrm(ks[8], (DEPTH, D_MIX, D_MODEL), D_MIX ** -0.5),
        "norm2_g": gain(ks[9], (DEPTH, D_MODEL)),
        "w_ff1": nrm(ks[10], (DEPTH, D_MODEL, D_FF), D_MODEL ** -0.5),
        "w_ff2": nrm(ks[11], (DEPTH, D_FF, D_MODEL), D_FF ** -0.5),
        "norm_f_g": gain(ks[12], (D_MODEL,)),
    }


def reference(x, norm1_g, w_in, w_gate_up, b_gate, conv_w, conv_norm_g, gla_norm_g,
              w_out, norm2_g, w_ff1, w_ff2, norm_f_g):
    bsz, seq, _ = x.shape
    split_at = [int(i) for i in np.cumsum(IN_SIZES)[:-1]]
    for l in range(DEPTH):
        u = rmsnorm(x, norm1_g[l])
        z = u @ w_in[l]
        cb, cc, ch, q, k, v, og, a_low = jnp.split(z, split_at, axis=-1)
        y_conv = short_conv_mixer(cb, cc, ch, conv_w[l], conv_norm_g[l])
        log_a = jax.nn.log_sigmoid(a_low @ w_gate_up[l] + b_gate[l]) / GATE_NORMALIZER
        o = gla_chunk_causal(q.reshape(bsz, seq, GLA_HEADS, GLA_DK),
                             k.reshape(bsz, seq, GLA_HEADS, GLA_DK),
                             v.reshape(bsz, seq, GLA_HEADS, GLA_DV),
                             log_a.reshape(bsz, seq, GLA_HEADS, GLA_DK))
        o = o * lax.rsqrt(jnp.mean(o * o, axis=-1, keepdims=True) + EPS)
        o = o * gla_norm_g[l].astype(jnp.float32) * jax.nn.silu(
            og.astype(jnp.float32).reshape(bsz, seq, GLA_HEADS, GLA_DV))
        y_gla = o.reshape(bsz, seq, D_GLA_V).astype(x.dtype)
        y = jnp.concatenate([y_conv, y_gla], axis=-1)
        x = x + y @ w_out[l]
        h = rmsnorm(x, norm2_g[l])
        x = x + jnp.square(jax.nn.relu(h @ w_ff1[l])) @ w_ff2[l]
    return rmsnorm(x, norm_f_g)
```

```cpp
#include <hip/hip_runtime.h>
#include <cstdio>
#include <cstdint>
namespace pg8 {
#define PG8_LAS __attribute__((address_space(3)))
typedef unsigned short bf16_t;
typedef short bf16x8 __attribute__((ext_vector_type(8)));
typedef float f32x4 __attribute__((ext_vector_type(4)));
typedef unsigned u32x4 __attribute__((ext_vector_type(4)));
constexpr int BM = 256, BK = 64, HALF = 128, HTB = HALF * BK * 2  , STAGE_BYTES = 8 * HTB, NXCD = 8, WGM = 8;

__host__ __device__ __forceinline__ int lds_byte(int r, int c) { const int st = (r >> 4) * 2 + (c >> 5), rr = r & 15, cc = c & 31, ob = rr * 64 + cc * 2; return st * 1024 + (ob ^ (((ob >> 9) & 1) << 5)); }
__host__ __device__ __forceinline__ void stage_rc(int b, int& R, int& C) { const int st = b / 1024, sb = b % 1024, swz = sb ^ (((sb >> 9) & 1) << 5); R = (st >> 1) * 16 + swz / 64; C = (st & 1) * 32 + (swz % 64) / 2; }
__host__ __device__ __forceinline__ int perm32(int rho) { const int n = rho >> 4, i = rho & 15; return 8 * (i >> 2) + 4 * n + (i & 3); }

struct Unit { int pm, pn; };
struct Gemm { const bf16_t* A; const bf16_t* Bt; int M, N, K; };

struct StaticOrder {
    int nM, nN, nwg, G, c;
    __host__ __device__ void init(int M, int N, int G_, int c_) { nM = M / BM; nN = N / BM; nwg = nM * nN; G = G_; c = c_; }
    __host__ __device__ bool next(int i, Unit& u) const {
        const long L = (long)i * G + c; if (L >= nwg) return false;
        int wgid = (int)L; { const int q = nwg / NXCD, r = nwg % NXCD, xcd = wgid % NXCD, off = wgid / NXCD; wgid = (xcd < r ? xcd * (q + 1) : r * (q + 1) + (xcd - r) * q) + off; }
        const int nig = WGM * nN, gid = wgid / nig, fm = gid * WGM, gsz = (nM - fm) < WGM ? (nM - fm) : WGM;
        u.pm = fm + ((wgid % nig) % gsz); u.pn = (wgid % nig) / gsz; return true;
    }
    __device__ __forceinline__ void a_ready(const Unit&) const {}
    __device__ __forceinline__ void done(const Unit&) const {}
};
__device__ __forceinline__ unsigned cvt_pk_bf16(float lo, float hi) { unsigned r; asm volatile("v_cvt_pk_bf16_f32 %0, %1, %2" : "=v"(r) : "v"(lo), "v"(hi)); return r; }
typedef float f32x2 __attribute__((ext_vector_type(2)));
typedef float f32x2 __attribute__((ext_vector_type(2)));
typedef unsigned u32x2 __attribute__((ext_vector_type(2)));
typedef __bf16 bf16x2_t __attribute__((ext_vector_type(2)));
__device__ __forceinline__ unsigned cvtpk(float lo, float hi) { f32x2 v = {lo, hi}; bf16x2_t b = __builtin_convertvector(v, bf16x2_t); return __builtin_bit_cast(unsigned, b); }

template <int ACT, int RS_MODE> struct EpiBf16Row {
    static constexpr bool PERM = true, AFTER_DRAIN = false;
    bf16_t* O; int ldc; const float* rs; float inv_n, eps;
    __device__ __forceinline__ void operator()(const f32x4 (&acc)[2][2][4][2], const Unit& u, int wr, int wc, int fr, int fq) const {
        const int row0 = u.pm * BM + wr * 64 + fr; const int col0 = u.pn * BM + wc * 32 + 8 * fq;
        float sc[2][4];
#pragma unroll
        for (int ai = 0; ai < 2; ++ai)
#pragma unroll
            for (int m = 0; m < 4; ++m) { float s = rs[row0 + ai * HALF + m * 16]; if (RS_MODE == 1) s = 1.0f / sqrtf(s * inv_n + eps); sc[ai][m] = s; }
#pragma unroll
        for (int ai = 0; ai < 2; ++ai)
#pragma unroll
            for (int m = 0; m < 4; ++m) { bf16_t* rowp = O + (size_t)(row0 + ai * HALF + m * 16) * ldc + col0; const float s = sc[ai][m];
#pragma unroll
                for (int bj = 0; bj < 2; ++bj) { f32x4 v0 = acc[ai][bj][m][0] * s, v1 = acc[ai][bj][m][1] * s;
                    if (ACT == 1) {
#pragma unroll
                        for (int i = 0; i < 4; ++i) { const float a = fmaxf(v0[i], 0.f), b = fmaxf(v1[i], 0.f); v0[i] = a * a; v1[i] = b * b; } }
                    u32x4 w; w.x = cvtpk(v0[0], v0[1]); w.y = cvtpk(v0[2], v0[3]); w.z = cvtpk(v1[0], v1[1]); w.w = cvtpk(v1[2], v1[3]);
                    *(u32x4*)(rowp + bj * HALF) = w; } }
    }
};

struct EpiResSq {
    static constexpr bool PERM = false, AFTER_DRAIN = false;
    const float* base; float* out; bf16_t* xn; const float* g; float* rowsq; int ldc;
    __device__ __forceinline__ void operator()(const f32x4 (&acc)[2][2][4][2], const Unit& u, int wr, int wc, int fr, int fq) const {
        const int col0 = u.pn * BM + wc * 32 + 4 * fq;
        f32x4 gv[2][2];
#pragma unroll
        for (int bj = 0; bj < 2; ++bj)
#pragma unroll
            for (int n = 0; n < 2; ++n) gv[bj][n] = xn ? *(const f32x4*)(g + col0 + bj * HALF + n * 16) : (f32x4){1.f, 1.f, 1.f, 1.f};
#pragma unroll
        for (int ai = 0; ai < 2; ++ai)
#pragma unroll
            for (int m = 0; m < 4; ++m) { const int r = u.pm * BM + ai * HALF + wr * 64 + m * 16 + fr; const size_t off = (size_t)r * ldc + col0; float s = 0.f;
#pragma unroll
                for (int bj = 0; bj < 2; ++bj)
#pragma unroll
                    for (int n = 0; n < 2; ++n) { const f32x4 bs = *(const f32x4*)(base + off + bj * HALF + n * 16); const f32x4 o = bs + acc[ai][bj][m][n];
                        *(f32x4*)(out + off + bj * HALF + n * 16) = o; s += (o[0] * o[0] + o[1] * o[1]) + (o[2] * o[2] + o[3] * o[3]);
                        if (xn) { const f32x4 t = o * gv[bj][n]; u32x2 w; w.x = cvtpk(t[0], t[1]); w.y = cvtpk(t[2], t[3]); *(u32x2*)(xn + off + bj * HALF + n * 16) = w; } }
                s += __shfl_xor(s, 16); s += __shfl_xor(s, 32);
                if (fq == 0) atomicAdd(rowsq + r, s);
                if (m & 1) asm volatile("" ::: "memory"); }
    }
};

template <class Epi, class Sched, bool ALIGN_EPI = false, bool SP2 = false>
__device__ __forceinline__ void gemm_phase(PG8_LAS unsigned char* lds, const Gemm g, const Sched& S, const Epi& E) {
    const int tid = threadIdx.x, wid = __builtin_amdgcn_readfirstlane(tid >> 6), lane = tid & 63, wr = wid >> 2, wc = wid & 3, fr = lane & 15, fq = lane >> 4;
    const int K = g.K, nt = K / BK;
    unsigned voffA[2], voffB[2];
#pragma unroll
    for (int i = 0; i < 2; ++i) { int R, C; stage_rc(tid * 16 + i * 8192, R, C); const int Rb = Epi::PERM ? ((R & ~31) + perm32(R & 31)) : R;
        voffA[i] = (unsigned)(R * K + C) * 2u; voffB[i] = (unsigned)(Rb * K + C) * 2u; }
    const size_t kstep = (size_t)(BK * 2);
    const size_t hstep = (size_t)HALF * K * 2;
    const size_t tstep = 2 * hstep;
    const unsigned ldsw = (unsigned)wid * 1024u;
    const int aoff = lds_byte(wr * 64 + fr, fq * 8), boff = lds_byte(wc * 32 + fr, fq * 8);
#define PG8_SA(b, h) (((b) * 2 + (h)) * HTB)
#define PG8_SB(b, h) ((4 + (b) * 2 + (h)) * HTB)
#define PG8_STAGE(bufoff, gbase, voff) do { _Pragma("unroll") for (int _i = 0; _i < 2; ++_i) \
        __builtin_amdgcn_global_load_lds((const unsigned*)((const char*)(gbase) + (voff)[_i]), (PG8_LAS unsigned*)(lds + (bufoff) + ldsw + _i * 8192), 16, 0, 0); } while (0)
#define PG8_LDA(dst, b, h) do { _Pragma("unroll") for (int m = 0; m < 4; ++m) _Pragma("unroll") for (int k = 0; k < 2; ++k) dst[m][k] = *(const PG8_LAS bf16x8*)(lds + PG8_SA(b, h) + aoff + m * 2048 + k * 1024); } while (0)
#define PG8_LDB(dst, b, h) do { _Pragma("unroll") for (int n = 0; n < 2; ++n) _Pragma("unroll") for (int k = 0; k < 2; ++k) dst[n][k] = *(const PG8_LAS bf16x8*)(lds + PG8_SB(b, h) + boff + n * 2048 + k * 1024); } while (0)
#define PG8_MMA(ai, bj, At, Bt) do { __builtin_amdgcn_s_setprio(1); _Pragma("unroll") for (int m = 0; m < 4; ++m) _Pragma("unroll") for (int n = 0; n < 2; ++n) _Pragma("unroll") for (int k = 0; k < 2; ++k) \
        acc[ai][bj][m][n] = __builtin_amdgcn_mfma_f32_16x16x32_bf16(Bt[n][k], At[m][k], acc[ai][bj][m][n], 0, 0, 0); __builtin_amdgcn_s_setprio(0); } while (0)
#define PG8_WAIT_V(n) asm volatile("s_waitcnt vmcnt(" #n ")" ::: "memory")
#define PG8_WAIT_L(n) asm volatile("s_waitcnt lgkmcnt(" #n ")" ::: "memory")
#define PG8_BAR __builtin_amdgcn_s_barrier()
#define PG8_SCHED __builtin_amdgcn_sched_barrier(0)
    Unit cur, nxt; int ui = 0;
    if (!S.next(0, cur)) return;
    f32x4 acc[2][2][4][2];
#pragma unroll
    for (int a = 0; a < 2; ++a)
#pragma unroll
        for (int b = 0; b < 2; ++b)
#pragma unroll
            for (int m = 0; m < 4; ++m)
#pragma unroll
                for (int n = 0; n < 2; ++n) acc[a][b][m][n] = (f32x4){0.f, 0.f, 0.f, 0.f};
    bf16x8 At[4][2], B0[2][2], B1[2][2];
    const char* cA = (const char*)g.A + (size_t)cur.pm * tstep; const char* cB = (const char*)g.Bt + (size_t)cur.pn * tstep;
    S.a_ready(cur);
    if constexpr (SP2) {
        PG8_STAGE(PG8_SB(0, 0), cB, voffB); PG8_STAGE(PG8_SB(0, 1), cB + hstep, voffB); PG8_STAGE(PG8_SA(0, 0), cA, voffA); PG8_STAGE(PG8_SA(0, 1), cA + hstep, voffA);
        if (wr == 1) PG8_BAR;
        PG8_WAIT_V(2); PG8_BAR;
        PG8_STAGE(PG8_SB(1, 0), cB + kstep, voffB); PG8_STAGE(PG8_SA(1, 0), cA + kstep, voffA); PG8_STAGE(PG8_SB(1, 1), cB + hstep + kstep, voffB);
        PG8_WAIT_V(6); PG8_BAR;
    } else {
        PG8_STAGE(PG8_SB(0, 0), cB, voffB); PG8_STAGE(PG8_SA(0, 0), cA, voffA); PG8_STAGE(PG8_SB(0, 1), cB + hstep, voffB); PG8_STAGE(PG8_SA(0, 1), cA + hstep, voffA);
        if (wr == 1) PG8_BAR;
        PG8_WAIT_V(4); PG8_BAR;
        PG8_STAGE(PG8_SB(1, 0), cB + kstep, voffB); PG8_STAGE(PG8_SA(1, 0), cA + kstep, voffA); PG8_STAGE(PG8_SB(1, 1), cB + hstep + kstep, voffB);
        PG8_WAIT_V(6); PG8_BAR;
    }
    for (;;) {
        const bool has_next = S.next(ui + 1, nxt);
        const char* nA = has_next ? (const char*)g.A + (size_t)nxt.pm * tstep : cA; const char* nB = has_next ? (const char*)g.Bt + (size_t)nxt.pn * tstep : cB;
        for (int t = 0; t < nt; t += 2) {
            const bool last = (t == nt - 2);
            const char* a1 = cA + (size_t)(t + 1) * kstep;
            const char* a2 = last ? nA : cA + (size_t)(t + 2) * kstep; const char* b2 = last ? nB : cB + (size_t)(t + 2) * kstep;
            const char* a3 = a2 + kstep; const char* b3 = b2 + kstep;
            if (last && has_next) S.a_ready(nxt);
            if constexpr (SP2) {
            PG8_LDB(B0, 0, 0); PG8_LDB(B1, 0, 1); PG8_SCHED; PG8_LDA(At, 0, 0); PG8_STAGE(PG8_SA(1, 1), a1 + hstep, voffA);
            PG8_WAIT_V(8); PG8_WAIT_L(0); PG8_BAR; PG8_MMA(0, 0, At, B0); PG8_MMA(0, 1, At, B1); PG8_BAR; PG8_SCHED;
            PG8_LDA(At, 0, 1); PG8_STAGE(PG8_SB(0, 0), b2, voffB); PG8_STAGE(PG8_SB(0, 1), b2 + hstep, voffB); PG8_STAGE(PG8_SA(0, 0), a2, voffA);
            PG8_WAIT_V(8); PG8_WAIT_L(0); PG8_BAR; PG8_MMA(1, 0, At, B0); PG8_MMA(1, 1, At, B1); PG8_BAR; PG8_SCHED;
            PG8_LDB(B0, 1, 0); PG8_LDB(B1, 1, 1); PG8_SCHED; PG8_LDA(At, 1, 0); PG8_STAGE(PG8_SA(0, 1), a2 + hstep, voffA);
            PG8_WAIT_V(8); PG8_WAIT_L(0); PG8_BAR; PG8_MMA(0, 0, At, B0); PG8_MMA(0, 1, At, B1); PG8_BAR; PG8_SCHED;
            PG8_LDA(At, 1, 1); PG8_STAGE(PG8_SB(1, 0), b3, voffB); PG8_STAGE(PG8_SB(1, 1), b3 + hstep, voffB); PG8_STAGE(PG8_SA(1, 0), a3, voffA);
            PG8_WAIT_V(8); PG8_WAIT_L(0); PG8_BAR; PG8_MMA(1, 0, At, B0); PG8_MMA(1, 1, At, B1); PG8_BAR; PG8_SCHED;
            } else {
            PG8_LDB(B0, 0, 0); PG8_SCHED; PG8_LDA(At, 0, 0); PG8_STAGE(PG8_SA(1, 1), a1 + hstep, voffA);
            PG8_WAIT_L(8); PG8_BAR; PG8_WAIT_L(0); PG8_MMA(0, 0, At, B0); PG8_BAR; PG8_SCHED;
            PG8_LDB(B1, 0, 1); PG8_STAGE(PG8_SB(0, 0), b2, voffB);
            PG8_BAR; PG8_WAIT_L(0); PG8_MMA(0, 1, At, B1); PG8_BAR;
            PG8_LDA(At, 0, 1); PG8_STAGE(PG8_SA(0, 0), a2, voffA);
            PG8_BAR; PG8_WAIT_L(0); PG8_MMA(1, 0, At, B0); PG8_BAR; PG8_SCHED;
            PG8_STAGE(PG8_SB(0, 1), b2 + hstep, voffB);
            PG8_WAIT_V(6); PG8_BAR; PG8_MMA(1, 1, At, B1); PG8_BAR;
            PG8_LDB(B0, 1, 0); PG8_SCHED; PG8_LDA(At, 1, 0); PG8_STAGE(PG8_SA(0, 1), a2 + hstep, voffA);
            PG8_WAIT_L(8); PG8_BAR; PG8_WAIT_L(0); PG8_MMA(0, 0, At, B0); PG8_BAR; PG8_SCHED;
            PG8_LDB(B1, 1, 1); PG8_STAGE(PG8_SB(1, 0), b3, voffB);
            PG8_BAR; PG8_WAIT_L(0); PG8_MMA(0, 1, At, B1); PG8_BAR;
            PG8_LDA(At, 1, 1); PG8_STAGE(PG8_SA(1, 0), a3, voffA);
            PG8_BAR; PG8_WAIT_L(0); PG8_MMA(1, 0, At, B0); PG8_BAR; PG8_SCHED;
            PG8_STAGE(PG8_SB(1, 1), b3 + hstep, voffB);
            PG8_WAIT_V(6); PG8_BAR; PG8_MMA(1, 1, At, B1); PG8_BAR;
            }
        }
        if constexpr (ALIGN_EPI) { if (wr == 0) PG8_BAR; }
        if constexpr (!Epi::AFTER_DRAIN) { E(acc, cur, wr, wc, fr, fq); S.done(cur); }
        if (!has_next) break;
#pragma unroll
        for (int a = 0; a < 2; ++a)
#pragma unroll
            for (int b = 0; b < 2; ++b)
#pragma unroll
                for (int m = 0; m < 4; ++m)
#pragma unroll
                    for (int n = 0; n < 2; ++n) acc[a][b][m][n] = (f32x4){0.f, 0.f, 0.f, 0.f};
        cur = nxt; cA = nA; cB = nB; ++ui;
        if constexpr (ALIGN_EPI) { if (wr == 1) PG8_BAR; }
    }
    PG8_WAIT_V(0);
    if constexpr (!ALIGN_EPI) { if (wr == 0) PG8_BAR; }
    PG8_BAR;
    if constexpr (Epi::AFTER_DRAIN) { E.fused(acc, cur, wr, wc, fr, fq, lds, wid, lane); S.done(cur); }
#undef PG8_SA
#undef PG8_SB
#undef PG8_STAGE
#undef PG8_LDA
#undef PG8_LDB
#undef PG8_MMA
#undef PG8_WAIT_V
#undef PG8_WAIT_L
#undef PG8_BAR
#undef PG8_SCHED
}
}
#ifndef PG8_SP2
#define PG8_SP2 true
#endif
#ifndef PG8_ALIGN
#define PG8_ALIGN true
#endif

constexpr int NWAVES = 8;
#ifndef MK_N_LAUNCHES
#define MK_N_LAUNCHES 1
#endif
constexpr int N_PHASES = 9;
constexpr int N_LAUNCHES = MK_N_LAUNCHES;
static_assert(N_LAUNCHES == 1 || N_LAUNCHES == N_PHASES, "MK_N_LAUNCHES is 1 or N_PHASES");

constexpr int BATCH = 2, SEQ = 8192, DM = 2048, M = BATCH * SEQ, FF = 8192;
constexpr int D_IN = 6160, NZ = 6144;
constexpr int ZCB = 0, ZCC = 1024, ZCH = 2048, ZQ = 3072, ZK = 3584, ZV = 4096, ZOG = 5120;
constexpr int NCHUNK = M / 64;
constexpr float EPS = 1e-6f;
constexpr float QSCALE = 0.08838834764831845f;

constexpr size_t MiB = 1u << 20;
constexpr size_t WS_CTL = 0, CTL_ZERO_BYTES = 1 * MiB;
constexpr size_t WS_WIN = 2 * MiB, WS_WOUT = 26 * MiB, WS_W1 = 34 * MiB, WS_W2 = 66 * MiB;
constexpr size_t WS_MISC = 98 * MiB;
constexpr size_t WS_ALOW = WS_MISC, WS_RSTD1 = WS_MISC + 1 * MiB, WS_DEC = WS_RSTD1 + 65536, WS_DRUN = WS_DEC + 524288;
constexpr size_t WS_XN = 100 * MiB;
constexpr size_t WS_RUNAGG = WS_XN, WS_SSTART = WS_XN + 32 * MiB;
constexpr size_t WS_Z = 164 * MiB;
constexpr size_t WS_Y = 356 * MiB;
constexpr size_t WS_H = 164 * MiB;
constexpr size_t WS_KDECT = 420 * MiB;
constexpr size_t WS_END = 436 * MiB;
static_assert(WS_W2 + (size_t)DM * FF * 2 <= WS_MISC && WS_DRUN + 131072 <= WS_XN && WS_XN + (size_t)M * DM * 2 <= WS_Z && WS_Z + (size_t)M * NZ * 2 <= WS_Y && WS_Y + (size_t)M * DM * 2 <= WS_KDECT && WS_H + (size_t)M * FF * 2 <= WS_KDECT, "d_ws map");
constexpr int CW_TMO = 0, CW_CODE = 1;
constexpr int CW_BAR = 4096;
constexpr int CW_ROWSQ1 = 65536, CW_ROWSQ2 = 65536 + M;
static_assert((CW_ROWSQ2 + M) * 4 <= (int)CTL_ZERO_BYTES, "CTL words inside the memset region");

constexpr int RING_OFF = 0, RING_BYTES = 131072;
constexpr int PHASE_LDS_MAX = 143360;
constexpr int LDSCTL_OFF = PHASE_LDS_MAX, MISC_OFF = LDSCTL_OFF + 320;
constexpr int LDS_BYTES = 147456;
static_assert(MISC_OFF + 128 <= LDS_BYTES, "LDS map");

#define GAS __attribute__((address_space(1)))
#define LAS __attribute__((address_space(3)))
typedef unsigned short bf16;
typedef unsigned v4u __attribute__((ext_vector_type(4)));
typedef unsigned v2u __attribute__((ext_vector_type(2)));
typedef float f32x4 __attribute__((ext_vector_type(4)));
typedef float f32x2 __attribute__((ext_vector_type(2)));
typedef float f32x16 __attribute__((ext_vector_type(16)));
typedef short bf16x8 __attribute__((ext_vector_type(8)));
typedef short bf16x4 __attribute__((ext_vector_type(4)));
typedef GAS unsigned gu32;
typedef GAS unsigned long long gu64;
#define RLX_AGENT __ATOMIC_RELAXED, __HIP_MEMORY_SCOPE_AGENT
#define LDS_WAIT() asm volatile("s_waitcnt lgkmcnt(0)" ::: "memory")
#define VM_WAIT() asm volatile("s_waitcnt vmcnt(0)" ::: "memory")
using pg8::cvtpk;
__device__ __forceinline__ float bflo(unsigned p) { return __uint_as_float(p << 16); }
__device__ __forceinline__ float bfhi(unsigned p) { return __uint_as_float(p & 0xffff0000u); }
__device__ __forceinline__ int crow(int reg, int hh) { return (reg & 3) + 8 * (reg >> 2) + 4 * hh; }
#define MFMA32(a, b, c) __builtin_amdgcn_mfma_f32_32x32x16_bf16((a), (b), (c), 0, 0, 0)
#define MFMA16(a, b, c) __builtin_amdgcn_mfma_f32_16x16x32_bf16((a), (b), (c), 0, 0, 0)

#define XB_TMO      128
#define XB_XCNT(j)  (256  + 64 * (j))
#define XB_XSUB(j)  (1280 + 64 * (j))
#define XB_XGEN(j)  (2304 + 64 * (j))
#define XB_TOP      3328
#define XB_TOPGEN   3392
#define XCD_BAR_WORDS 3456
#define XB_SPIN_CAP (1u << 18)

__device__ __forceinline__ unsigned xb_ld(unsigned* p)              { return __hip_atomic_load(p, __ATOMIC_RELAXED, __HIP_MEMORY_SCOPE_AGENT); }
__device__ __forceinline__ unsigned xb_add(unsigned* p, unsigned v) { return __hip_atomic_fetch_add(p, v, __ATOMIC_RELAXED, __HIP_MEMORY_SCOPE_AGENT); }
__device__ __forceinline__ unsigned xb_xcc_id() { return (unsigned)__builtin_amdgcn_s_getreg((3 << 11) | 20) & 0xFu; }
#define XB_SPIN(cond, bar) do { unsigned _sp = 0; while (cond) { __builtin_amdgcn_s_sleep(1); \
    if ((++_sp & 255u) == 0u) { if (xb_ld(&(bar)[XB_TMO])) break; if (_sp > XB_SPIN_CAP) { atomicAdd(&(bar)[XB_TMO], 1u); break; } } } } while (0)

struct XcdBarrier {
    unsigned* bar; unsigned x;
    volatile LAS unsigned* st;
};

__device__ __forceinline__ XcdBarrier xcd_barrier_post(unsigned* bar, volatile LAS unsigned* st) {
    XcdBarrier b; b.bar = bar; b.x = xb_xcc_id(); b.st = st;
    if (threadIdx.x == 0) (void)xb_add(&bar[XB_XCNT(b.x)], 1u);
    return b;
}
__device__ __forceinline__ void xcd_barrier_complete(unsigned* bar, unsigned x, unsigned& nloc, unsigned& nx) {
    const unsigned G = gridDim.x * gridDim.y * gridDim.z;
    unsigned sum, cnt, mine, sp = 0u;
    for (;;) {
        sum = 0u; cnt = 0u; mine = 0u;
#pragma unroll
        for (unsigned j = 0; j < 16; ++j) { const unsigned c = xb_ld(&bar[XB_XCNT(j)]); sum += c; cnt += (c > 0u) ? 1u : 0u; mine = (j == x) ? c : mine; }
        if (sum == G) break;
        __builtin_amdgcn_s_sleep(1);
        if ((++sp & 255u) == 0u) { if (xb_ld(&bar[XB_TMO])) break; if (sp > XB_SPIN_CAP) { atomicAdd(&bar[XB_TMO], 1u); break; } }
    }
    nloc = mine > 0u ? mine : 1u; nx = cnt > 0u ? cnt : 1u;
}

__device__ __forceinline__ void xcd_barrier(const XcdBarrier& b) {
    asm volatile("s_waitcnt vmcnt(0)" ::: "memory");
    __syncthreads();
    if (threadIdx.x == 0) {
        unsigned* bar = b.bar;
        __builtin_amdgcn_s_waitcnt(0);
        unsigned nloc = b.st[0], nx = b.st[1];
        if (nloc == 0u) { xcd_barrier_complete(bar, b.x, nloc, nx); b.st[0] = nloc; b.st[1] = nx; }
        const unsigned old = xb_add(&bar[XB_XSUB(b.x)], 1u);
        const unsigned gen = old / nloc;
        if (old + 1u == (gen + 1u) * nloc) {
            __builtin_amdgcn_fence(__ATOMIC_RELEASE, "agent");
            asm volatile("s_waitcnt vmcnt(0)" ::: "memory");
            const unsigned og = xb_add(&bar[XB_TOP], 1u);
            const unsigned tg = og / nx;
            if (og + 1u == (tg + 1u) * nx) xb_add(&bar[XB_TOPGEN], 1u);
            else XB_SPIN(xb_ld(&bar[XB_TOPGEN]) == tg, bar);
            __builtin_amdgcn_fence(__ATOMIC_ACQUIRE, "agent");
            xb_add(&bar[XB_XGEN(b.x)], 1u);
            asm volatile("s_waitcnt vmcnt(0)" ::: "memory");
        } else {
            XB_SPIN(xb_ld(&bar[XB_XGEN(b.x)]) == gen, bar);
            __builtin_amdgcn_fence(__ATOMIC_ACQUIRE, "agent");
            asm volatile("s_waitcnt vmcnt(0)" ::: "memory");
        }
    }
    __syncthreads();
}
struct Frame {
    LAS unsigned char* lds;
    volatile LAS unsigned* MISC;
    gu32* ctl;
    int tid, lane, wave;
    int vcu, G;
    const float *x, *g1, *w_in, *wgate, *bgate, *conv_w, *conv_g, *gla_g, *w_out, *g2, *w1, *w2, *gf;
    float* out;
    bf16 *WIN_T, *WOUT_T, *W1_T, *W2_T;
    bf16 *XN, *Z, *Y, *H, *KDECT;
    float *ALOW, *RSTD1, *DEC, *DRUN, *RUNAGG, *SSTART, *ROWSQ1, *ROWSQ2;
};

__device__ __forceinline__ void p0_transpose_item(const float* W, int ldw, int K, int nblk, bf16* WT, LAS float* scr, int item, int lane) {
    const int kb = item / nblk, nb = item % nblk, k0 = 64 * kb, n0 = 32 * nb;
#pragma unroll 8
    for (int i = 0; i < 32; ++i) { const int kk = 2 * i + (lane >> 5); scr[kk * 33 + (lane & 31)] = W[(size_t)(k0 + kk) * ldw + n0 + (lane & 31)]; }
    LDS_WAIT(); asm volatile("" ::: "memory");
    const int c = lane & 7;
#pragma unroll
    for (int j = 0; j < 4; ++j) { const int n = (lane >> 3) + 8 * j; const LAS float* s = scr + (8 * c) * 33 + n;
        v4u o; o.x = cvtpk(s[0 * 33], s[1 * 33]); o.y = cvtpk(s[2 * 33], s[3 * 33]); o.z = cvtpk(s[4 * 33], s[5 * 33]); o.w = cvtpk(s[6 * 33], s[7 * 33]);
        *(GAS v4u*)(WT + (size_t)(n0 + n) * K + k0 + 8 * c) = o; }
    LDS_WAIT(); asm volatile("" ::: "memory");
}
__device__ __forceinline__ void p0_x_item(Frame& F, int item, const LAS v4u* WA, const LAS float* G1) {
    const int lane = F.lane, fr = lane & 15, fq = lane >> 4;
    const int row = item * 16 + fr;
    const float* xr = F.x + (size_t)row * DM + 16 * fq;
    bf16* xo = F.XN + (size_t)row * DM + 16 * fq;
    const LAS float* gp = G1 + 16 * fq;
    f32x4 acc = {0.f, 0.f, 0.f, 0.f}; float ss = 0.f;
#pragma unroll 4
    for (int sp = 0; sp < 32; ++sp) {
        f32x4 xv[4], p[4];
#pragma unroll
        for (int i = 0; i < 4; ++i) xv[i] = *(const f32x4*)(xr + 64 * sp + 4 * i);
#pragma unroll
        for (int i = 0; i < 4; ++i) { const f32x4 gv = *(const LAS f32x4*)(gp + 64 * sp + 4 * i); ss += (xv[i][0] * xv[i][0] + xv[i][1] * xv[i][1]) + (xv[i][2] * xv[i][2] + xv[i][3] * xv[i][3]); p[i] = xv[i] * gv; }
        v4u a0, a1;
        a0.x = cvtpk(p[0][0], p[0][1]); a0.y = cvtpk(p[0][2], p[0][3]); a0.z = cvtpk(p[1][0], p[1][1]); a0.w = cvtpk(p[1][2], p[1][3]);
        a1.x = cvtpk(p[2][0], p[2][1]); a1.y = cvtpk(p[2][2], p[2][3]); a1.z = cvtpk(p[3][0], p[3][1]); a1.w = cvtpk(p[3][2], p[3][3]);
        *(GAS v4u*)(xo + 64 * sp) = a0; *(GAS v4u*)(xo + 64 * sp + 8) = a1;
        const v4u b0 = WA[(2 * sp) * 64 + lane], b1 = WA[(2 * sp + 1) * 64 + lane];
        acc = MFMA16(__builtin_bit_cast(bf16x8, a0), __builtin_bit_cast(bf16x8, b0), acc);
        acc = MFMA16(__builtin_bit_cast(bf16x8, a1), __builtin_bit_cast(bf16x8, b1), acc);
    }
    ss += __shfl_xor(ss, 16); ss += __shfl_xor(ss, 32);
    const float rstd = 1.0f / sqrtf(ss * (1.0f / DM) + EPS);
    if (fq == 0) F.RSTD1[row] = rstd;
#pragma unroll
    for (int reg = 0; reg < 4; ++reg) { const float rr = __shfl(rstd, 4 * fq + reg); F.ALOW[(size_t)(item * 16 + 4 * fq + reg) * 16 + fr] = acc[reg] * rr; }
}
__device__ __forceinline__ void p0_prologue(Frame& F) {
    LAS v4u* WA = (LAS v4u*)(F.lds);
    LAS float* G1 = (LAS float*)(F.lds + 65536);
    LAS float* scr = (LAS float*)(F.lds + 73728 + F.wave * 8448);
    static_assert(73728 + NWAVES * 8448 <= PHASE_LDS_MAX, "P0 LDS");
    for (int idx = F.tid; idx < 4096; idx += NWAVES * 64) {
        const int sp = idx >> 6, l = idx & 63, fq = l >> 4, fr = l & 15;
        const int kb = 64 * (sp >> 1) + 16 * fq + 8 * (sp & 1);
        const float* src = F.w_in + (size_t)kb * D_IN + NZ + fr;
        float v[8];
#pragma unroll
        for (int j = 0; j < 8; ++j) v[j] = src[(size_t)j * D_IN];
        v4u o; o.x = cvtpk(v[0], v[1]); o.y = cvtpk(v[2], v[3]); o.z = cvtpk(v[4], v[5]); o.w = cvtpk(v[6], v[7]);
        WA[idx] = o;
    }
    for (int i = F.tid; i < DM; i += NWAVES * 64) G1[i] = F.g1[i];
    __syncthreads();
    for (int it = F.wave * F.G + F.vcu; it < M / 16; it += NWAVES * F.G) p0_x_item(F, it, WA, G1);
    const int gw = F.vcu * NWAVES + F.wave, NGW = F.G * NWAVES;
    constexpr int I_IN = (DM / 64) * (NZ / 32), I_OUT = (DM / 64) * (DM / 32), I_1 = (DM / 64) * (FF / 32), I_2 = (FF / 64) * (DM / 32);
    constexpr int NITEMS = I_IN + I_OUT + I_1 + I_2;
    for (int it = gw; it < NITEMS; it += NGW) {
        int r = it;
        if (r < I_IN) { p0_transpose_item(F.w_in, D_IN, DM, NZ / 32, F.WIN_T, scr, r, F.lane); continue; } r -= I_IN;
        if (r < I_OUT) { p0_transpose_item(F.w_out, DM, DM, DM / 32, F.WOUT_T, scr, r, F.lane); continue; } r -= I_OUT;
        if (r < I_1) { p0_transpose_item(F.w1, FF, DM, FF / 32, F.W1_T, scr, r, F.lane); continue; } r -= I_1;
        p0_transpose_item(F.w2, DM, FF, DM / 32, F.W2_T, scr, r, F.lane);
    }
}

__device__ __forceinline__ void p2_gate_runagg(Frame& F) {
    LAS float* AL = (LAS float*)(F.lds);
    LAS unsigned char* KDT = F.lds + 16384;
    LAS unsigned char* VT = F.lds + 16384 + 73728;
    LAS float* DECS = (LAS float*)(F.lds + 16384 + 73728 + 33792);
    const int tid = F.tid, lane = F.lane, w = F.wave, l31 = lane & 31, hh = lane >> 5;
    for (int uid = blockIdx.x; uid < 256; uid += F.G) {
        const int b = uid >> 7, r = (uid >> 2) & 31, h = uid & 3;
        const int row0 = b * SEQ + r * 256;
        __syncthreads();
        { const GAS f32x4* src = (const GAS f32x4*)(F.ALOW + (size_t)row0 * 16); for (int i = tid; i < 1024; i += NWAVES * 64) ((LAS f32x4*)AL)[i] = src[i]; }
        __syncthreads();
        {   const int j = tid >> 7, col = tid & 127, gcol = h * 128 + col;
            float wg[16];
#pragma unroll
            for (int rr = 0; rr < 16; ++rr) wg[rr] = F.wgate[rr * 512 + gcol];
            const float bgv = F.bgate[gcol];
            const bf16* kp = F.Z + (size_t)(row0 + j * 64) * NZ + ZK + gcol;
            bf16* kdt_g = F.KDECT + ((size_t)((b * 128 + r * 4 + j) * 4 + h) * 128 + col) * 64;
            float rs = 0.f;
            for (int t8 = 7; t8 >= 0; --t8) {
                float kd[8];
#pragma unroll
                for (int tt = 7; tt >= 0; --tt) {
                    const int t = t8 * 8 + tt;
                    const LAS f32x4* ap = (const LAS f32x4*)(AL + (j * 64 + t) * 16);
                    const f32x4 a0 = ap[0], a1 = ap[1], a2 = ap[2], a3 = ap[3];
                    float pre = bgv;
                    pre += a0[0] * wg[0] + a0[1] * wg[1] + a0[2] * wg[2] + a0[3] * wg[3];
                    pre += a1[0] * wg[4] + a1[1] * wg[5] + a1[2] * wg[6] + a1[3] * wg[7];
                    pre += a2[0] * wg[8] + a2[1] * wg[9] + a2[2] * wg[10] + a2[3] * wg[11];
                    pre += a3[0] * wg[12] + a3[1] * wg[13] + a3[2] * wg[14] + a3[3] * wg[15];
                    const float la = (fminf(pre, 0.f) - __logf(1.f + __expf(-fabsf(pre)))) * (1.0f / 16.0f);
                    const float kv = __uint_as_float((unsigned)kp[(size_t)t * NZ] << 16);
                    kd[tt] = kv * __expf(rs);
                    rs += la;
                }
                v4u o; o.x = cvtpk(kd[0], kd[1]); o.y = cvtpk(kd[2], kd[3]); o.z = cvtpk(kd[4], kd[5]); o.w = cvtpk(kd[6], kd[7]);
                *(LAS v4u*)(KDT + (j * 128 + col) * 144 + t8 * 16) = o;
                *(GAS v4u*)(kdt_g + t8 * 8) = o;
            }
            const float dec = __expf(rs);
            DECS[j * 128 + col] = dec;
            F.DEC[(size_t)(b * 128 + r * 4 + j) * 512 + gcol] = dec;
        }
        __syncthreads();
        if (tid < 128) F.DRUN[(size_t)uid * 128 + tid] = (DECS[tid] * DECS[128 + tid]) * (DECS[256 + tid] * DECS[384 + tid]);
        f32x16 S[4];
#pragma unroll
        for (int kb = 0; kb < 4; ++kb)
#pragma unroll
            for (int reg = 0; reg < 16; ++reg) S[kb][reg] = 0.f;
        for (int j = 0; j < 4; ++j) {
            if (j) __syncthreads();
            for (int i = tid; i < 2048; i += NWAVES * 64) { const int t = i >> 5, c16 = i & 31;
                const v4u v = *(const GAS v4u*)(F.Z + (size_t)(row0 + j * 64 + t) * NZ + ZV + h * 256 + c16 * 8); *(LAS v4u*)(VT + t * 528 + c16 * 16) = v; }
            __syncthreads();
            if (j) {
#pragma unroll
                for (int kb = 0; kb < 4; ++kb)
#pragma unroll
                    for (int reg = 0; reg < 16; ++reg) S[kb][reg] *= DECS[j * 128 + 32 * kb + crow(reg, hh)];
            }
#pragma unroll
            for (int s = 0; s < 4; ++s) {
                bf16x8 bfrag;
#pragma unroll
                for (int jj = 0; jj < 8; ++jj) bfrag[jj] = *(const LAS short*)(VT + (16 * s + 8 * hh + jj) * 528 + (32 * w + l31) * 2);
#pragma unroll
                for (int kb = 0; kb < 4; ++kb) { const bf16x8 afrag = *(const LAS bf16x8*)(KDT + (j * 128 + 32 * kb + l31) * 144 + (16 * s + 8 * hh) * 2); S[kb] = MFMA32(afrag, bfrag, S[kb]); }
            }
        }
        float* dst = F.RUNAGG + ((size_t)uid * 8 + w) * 4096 + lane;
#pragma unroll
        for (int kb = 0; kb < 4; ++kb)
#pragma unroll
            for (int reg = 0; reg < 16; ++reg) dst[kb * 1024 + reg * 64] = S[kb][reg];
    }
}

__device__ __forceinline__ void p3_scan(Frame& F) {
    const int nthr = F.G * NWAVES * 64;
    for (int e = blockIdx.x * NWAVES * 64 + F.tid; e < 131072; e += nthr) {
        const int bh = e >> 14, idx = (e & 16383) * 2, b = bh >> 2, h = bh & 3;
        const int kb = (idx >> 10) & 3, reg = (idx >> 6) & 15, ln = idx & 63, k = 32 * kb + crow(reg, ln >> 5);
        float sx = 0.f, sy = 0.f;
#pragma unroll 8
        for (int r = 0; r < 32; ++r) {
            const size_t uid = (size_t)(b * 32 + r) * 4 + h, off = uid * 32768 + idx;
            *(GAS f32x2*)(F.SSTART + off) = (f32x2){sx, sy};
            const float d = F.DRUN[uid * 128 + k]; const f32x2 a = *(const GAS f32x2*)(F.RUNAGG + off);
            sx = d * sx + a[0]; sy = d * sy + a[1];
        }
    }
}
__device__ __forceinline__ float wave_sum(float v) {
#pragma unroll
    for (int o = 1; o < 64; o <<= 1) v += __shfl_xor(v, o);
    return v;
}
__device__ __forceinline__ void p3_conv(Frame& F) {
    for (int c = blockIdx.x; c < NCHUNK; c += F.G) {
        const int ch = F.tid * 2, row0 = c * 64; const bool first = (c & 127) == 0;
        const float w00 = F.conv_w[ch * 3 + 0], w01 = F.conv_w[ch * 3 + 1], w02 = F.conv_w[ch * 3 + 2];
        const float w10 = F.conv_w[ch * 3 + 3], w11 = F.conv_w[ch * 3 + 4], w12 = F.conv_w[ch * 3 + 5];
        const float g0 = F.conv_g[ch], g1 = F.conv_g[ch + 1];
        float um2x = 0.f, um2y = 0.f, um1x = 0.f, um1y = 0.f;
        if (!first) {
            const bf16* z2 = F.Z + (size_t)(row0 - 2) * NZ; const bf16* z1 = F.Z + (size_t)(row0 - 1) * NZ;
            const unsigned c2 = *(const GAS unsigned*)(z2 + ZCC + ch), h2 = *(const GAS unsigned*)(z2 + ZCH + ch), c1 = *(const GAS unsigned*)(z1 + ZCC + ch), h1 = *(const GAS unsigned*)(z1 + ZCH + ch);
            um2x = bflo(c2) * bflo(h2); um2y = bfhi(c2) * bfhi(h2); um1x = bflo(c1) * bflo(h1); um1y = bfhi(c1) * bfhi(h1);
        }
#pragma unroll 4
        for (int t = 0; t < 64; ++t) {
            const bf16* zr = F.Z + (size_t)(row0 + t) * NZ;
            const unsigned cbp = *(const GAS unsigned*)(zr + ZCB + ch), ccp = *(const GAS unsigned*)(zr + ZCC + ch), chp = *(const GAS unsigned*)(zr + ZCH + ch);
            const float ux = bflo(ccp) * bflo(chp), uy = bfhi(ccp) * bfhi(chp);
            const float cx = um2x * w00 + um1x * w01 + ux * w02, cy = um2y * w10 + um1y * w11 + uy * w12;
            const float yx = bflo(cbp) * cx, yy = bfhi(cbp) * cy;
            const float ss = wave_sum(yx * yx + yy * yy);
            const float rstd = 1.0f / sqrtf(ss * (1.0f / 128.0f) + EPS);
            *(GAS unsigned*)(F.Y + (size_t)(row0 + t) * DM + ch) = cvtpk(yx * rstd * g0, yy * rstd * g1);
            um2x = um1x; um2y = um1y; um1x = ux; um1y = uy;
        }
    }
}

__device__ __forceinline__ void p4_gla_out(Frame& F) {
    LAS unsigned char* KDT = F.lds;
    LAS unsigned char* VT = F.lds + 18432;
    LAS unsigned char* QT = F.lds + 18432 + 33792;
    LAS float* DECS = (LAS float*)(F.lds + 69632);
    LAS float* RS = (LAS float*)(F.lds + 69632 + 512);
    const int tid = F.tid, lane = F.lane, w = F.wave, l31 = lane & 31, hh = lane >> 5;
    for (int uid = blockIdx.x; uid < 256; uid += F.G) {
        const int b = uid >> 7, r = (uid >> 2) & 31, h = uid & 3;
        const int row0 = b * SEQ + r * 256;
        f32x16 S[4];
        { const float* src = F.SSTART + ((size_t)uid * 8 + w) * 4096 + lane;
#pragma unroll
          for (int kb = 0; kb < 4; ++kb)
#pragma unroll
              for (int reg = 0; reg < 16; ++reg) S[kb][reg] = src[kb * 1024 + reg * 64]; }
        f32x4 gn[4];
#pragma unroll
        for (int g = 0; g < 4; ++g) gn[g] = *(const f32x4*)(F.gla_g + 32 * w + 8 * g + 4 * hh);
        for (int j = 0; j < 4; ++j) {
            const int rowc = row0 + j * 64, chunk = b * 128 + r * 4 + j;
            __syncthreads();
            { const GAS v4u* src = (const GAS v4u*)(F.KDECT + (size_t)(chunk * 4 + h) * 128 * 64);
              for (int i = tid; i < 1024; i += NWAVES * 64) { const int k = i >> 3, p = i & 7; *(LAS v4u*)(KDT + k * 144 + p * 16) = src[i]; } }
            for (int i = tid; i < 2048; i += NWAVES * 64) { const int t = i >> 5, c16 = i & 31;
                const v4u v = *(const GAS v4u*)(F.Z + (size_t)(rowc + t) * NZ + ZV + h * 256 + c16 * 8); *(LAS v4u*)(VT + t * 528 + c16 * 16) = v; }
            for (int i = tid; i < 1024; i += NWAVES * 64) { const int t = i >> 4, p = i & 15;
                const v4u v = *(const GAS v4u*)(F.Z + (size_t)(rowc + t) * NZ + ZQ + h * 128 + p * 8); *(LAS v4u*)(QT + t * 272 + p * 16) = v; }
            if (tid < 128) DECS[tid] = F.DEC[(size_t)chunk * 512 + h * 128 + tid];
            __syncthreads();
#pragma unroll
            for (int kb = 0; kb < 4; ++kb)
#pragma unroll
                for (int reg = 0; reg < 16; ++reg) S[kb][reg] *= DECS[32 * kb + crow(reg, hh)];
#pragma unroll
            for (int s = 0; s < 4; ++s) {
                bf16x8 bfrag;
#pragma unroll
                for (int jj = 0; jj < 8; ++jj) bfrag[jj] = *(const LAS short*)(VT + (16 * s + 8 * hh + jj) * 528 + (32 * w + l31) * 2);
#pragma unroll
                for (int kb = 0; kb < 4; ++kb) { const bf16x8 afrag = *(const LAS bf16x8*)(KDT + (32 * kb + l31) * 144 + (16 * s + 8 * hh) * 2); S[kb] = MFMA32(afrag, bfrag, S[kb]); }
            }
            bf16x8 Sb[4][2];
#pragma unroll
            for (int kb = 0; kb < 4; ++kb)
#pragma unroll
                for (int s = 0; s < 2; ++s) { v4u p; p.x = cvtpk(S[kb][8 * s + 0], S[kb][8 * s + 1]); p.y = cvtpk(S[kb][8 * s + 2], S[kb][8 * s + 3]); p.z = cvtpk(S[kb][8 * s + 4], S[kb][8 * s + 5]); p.w = cvtpk(S[kb][8 * s + 6], S[kb][8 * s + 7]);
                    Sb[kb][s] = __builtin_bit_cast(bf16x8, p); }
            f32x16 oT[2];
#pragma unroll
            for (int tb = 0; tb < 2; ++tb) {
#pragma unroll
                for (int reg = 0; reg < 16; ++reg) oT[tb][reg] = 0.f;
#pragma unroll
                for (int kb = 0; kb < 4; ++kb)
#pragma unroll
                    for (int s = 0; s < 2; ++s) { const LAS unsigned char* qp = QT + (32 * tb + l31) * 272 + (32 * kb + 16 * s + 4 * hh) * 2;
                        const bf16x4 lo = *(const LAS bf16x4*)qp, hi = *(const LAS bf16x4*)(qp + 16);
                        const bf16x8 pb = __builtin_shufflevector(lo, hi, 0, 1, 2, 3, 4, 5, 6, 7);
                        oT[tb] = MFMA32(Sb[kb][s], pb, oT[tb]); }
            }
#pragma unroll
            for (int tb = 0; tb < 2; ++tb) { float ss = 0.f;
#pragma unroll
                for (int reg = 0; reg < 16; ++reg) { oT[tb][reg] *= QSCALE; ss += oT[tb][reg] * oT[tb][reg]; }
                ss += __shfl_xor(ss, 32);
                if (hh == 0) RS[(32 * tb + l31) * 8 + w] = ss; }
            __syncthreads();
#pragma unroll
            for (int tb = 0; tb < 2; ++tb) { const int t = 32 * tb + l31;
                const LAS f32x4* rp = (const LAS f32x4*)(RS + t * 8); const f32x4 r0 = rp[0], r1 = rp[1];
                const float tot = ((r0[0] + r0[1]) + (r0[2] + r0[3])) + ((r1[0] + r1[1]) + (r1[2] + r1[3]));
                const float rstd = 1.0f / sqrtf(tot * (1.0f / 256.0f) + EPS);
                const bf16* ogp = F.Z + (size_t)(rowc + t) * NZ + ZOG + h * 256 + 32 * w + 4 * hh;
                bf16* yp = F.Y + (size_t)(rowc + t) * DM + 1024 + h * 256 + 32 * w + 4 * hh;
#pragma unroll
                for (int g = 0; g < 4; ++g) { const v2u og2 = *(const GAS v2u*)(ogp + 8 * g);
                    const float og0 = bflo(og2.x), og1 = bfhi(og2.x), og2f = bflo(og2.y), og3 = bfhi(og2.y);
                    const float y0 = oT[tb][4 * g + 0] * rstd * gn[g][0] * (og0 / (1.f + __expf(-og0)));
                    const float y1 = oT[tb][4 * g + 1] * rstd * gn[g][1] * (og1 / (1.f + __expf(-og1)));
                    const float y2 = oT[tb][4 * g + 2] * rstd * gn[g][2] * (og2f / (1.f + __expf(-og2f)));
                    const float y3 = oT[tb][4 * g + 3] * rstd * gn[g][3] * (og3 / (1.f + __expf(-og3)));
                    v2u o; o.x = cvtpk(y0, y1); o.y = cvtpk(y2, y3); *(GAS v2u*)(yp + 8 * g) = o; } }
        }
    }
}

__device__ __forceinline__ void p8_final_norm(Frame& F) {
    const int gw = F.vcu * NWAVES + F.wave, NGW = F.G * NWAVES;
    f32x4 gv[8];
#pragma unroll
    for (int j = 0; j < 8; ++j) gv[j] = *(const f32x4*)(F.gf + 4 * F.lane + 256 * j);
    for (int m = gw; m < M; m += NGW) {
        const float rstd = 1.0f / sqrtf(F.ROWSQ2[m] * (1.0f / DM) + EPS);
        GAS f32x4* o = (GAS f32x4*)(F.out + (size_t)m * DM) + F.lane;
        f32x4 v[8];
#pragma unroll
        for (int j = 0; j < 8; ++j) v[j] = o[64 * j];
#pragma unroll
        for (int j = 0; j < 8; ++j) o[64 * j] = v[j] * rstd * gv[j];
    }
}

struct Args { const float* in[13]; float* out; unsigned char* ws; int ph_lo, ph_hi, li, pad; };
__global__ void __launch_bounds__(NWAVES * 64, 2) skel_fwd(Args args) {
    extern __shared__ __attribute__((aligned(16))) unsigned char lds[];
    Frame F;
    F.lds = (LAS unsigned char*)lds;
    F.MISC = (volatile LAS unsigned*)(F.lds + MISC_OFF);
    F.tid = threadIdx.x; F.lane = F.tid & 63; F.wave = __builtin_amdgcn_readfirstlane(F.tid >> 6);
    F.G = gridDim.x; { const int bx = blockIdx.x; F.vcu = (F.G % 8 == 0) ? (bx % 8) * (F.G / 8) + bx / 8 : bx; }
    unsigned char* ws = args.ws;
    F.ctl = (gu32*)(ws + WS_CTL);
    F.x = args.in[0]; F.g1 = args.in[1]; F.w_in = args.in[2]; F.wgate = args.in[3]; F.bgate = args.in[4]; F.conv_w = args.in[5]; F.conv_g = args.in[6];
    F.gla_g = args.in[7]; F.w_out = args.in[8]; F.g2 = args.in[9]; F.w1 = args.in[10]; F.w2 = args.in[11]; F.gf = args.in[12]; F.out = args.out;
    F.WIN_T = (bf16*)(ws + WS_WIN); F.WOUT_T = (bf16*)(ws + WS_WOUT); F.W1_T = (bf16*)(ws + WS_W1); F.W2_T = (bf16*)(ws + WS_W2);
    F.XN = (bf16*)(ws + WS_XN); F.Z = (bf16*)(ws + WS_Z); F.Y = (bf16*)(ws + WS_Y); F.H = (bf16*)(ws + WS_H); F.KDECT = (bf16*)(ws + WS_KDECT);
    F.ALOW = (float*)(ws + WS_ALOW); F.RSTD1 = (float*)(ws + WS_RSTD1); F.DEC = (float*)(ws + WS_DEC); F.DRUN = (float*)(ws + WS_DRUN);
    F.RUNAGG = (float*)(ws + WS_RUNAGG); F.SSTART = (float*)(ws + WS_SSTART);
    F.ROWSQ1 = (float*)(ws + WS_CTL) + CW_ROWSQ1; F.ROWSQ2 = (float*)(ws + WS_CTL) + CW_ROWSQ2;
    for (int u = F.tid; u < (LDS_BYTES - LDSCTL_OFF) / 4; u += NWAVES * 64) ((LAS unsigned*)(F.lds + LDSCTL_OFF))[u] = 0u;
    __syncthreads();
    XcdBarrier bar; bar.bar = (unsigned*)(F.ctl + CW_BAR); bar.x = 0; bar.st = nullptr;
    if (N_LAUNCHES == 1) bar = xcd_barrier_post((unsigned*)(F.ctl + CW_BAR), F.MISC + 8);
#define GRID_BAR() do { if (N_LAUNCHES == 1) { xcd_barrier(bar); } } while (0)
    const int lo = args.ph_lo, hi = args.ph_hi;
#define IN(k) (lo <= (k) && (k) < hi)
#define BOTH(k) (IN(k) && IN((k) + 1))

    if (IN(0)) { p0_prologue(F); if (BOTH(0)) GRID_BAR(); }

    if (IN(1)) {
        pg8::Gemm g{F.XN, F.WIN_T, M, NZ, DM}; pg8::StaticOrder S; S.init(M, NZ, F.G, (int)blockIdx.x);
        pg8::EpiBf16Row<0, 0> E{F.Z, NZ, F.RSTD1, 0.f, 0.f};
        pg8::gemm_phase<pg8::EpiBf16Row<0, 0>, pg8::StaticOrder, PG8_ALIGN, PG8_SP2>(F.lds + RING_OFF, g, S, E);
        if (BOTH(1)) GRID_BAR();
    }
    if (IN(2)) { p2_gate_runagg(F); if (BOTH(2)) GRID_BAR(); }
    if (IN(3)) { p3_scan(F); p3_conv(F); if (BOTH(3)) GRID_BAR(); }
    if (IN(4)) { p4_gla_out(F); if (BOTH(4)) GRID_BAR(); }
    if (IN(5)) {
        pg8::Gemm g{F.Y, F.WOUT_T, M, DM, DM}; pg8::StaticOrder S; S.init(M, DM, F.G, (int)blockIdx.x);
        pg8::EpiResSq E{F.x, F.out, F.XN, F.g2, F.ROWSQ1, DM};
        pg8::gemm_phase<pg8::EpiResSq, pg8::StaticOrder, PG8_ALIGN, PG8_SP2>(F.lds + RING_OFF, g, S, E);
        if (BOTH(5)) GRID_BAR();
    }
    if (IN(6)) {
        pg8::Gemm g{F.XN, F.W1_T, M, FF, DM}; pg8::StaticOrder S; S.init(M, FF, F.G, (int)blockIdx.x);
        pg8::EpiBf16Row<1, 1> E{F.H, FF, F.ROWSQ1, 1.0f / DM, EPS};
        pg8::gemm_phase<pg8::EpiBf16Row<1, 1>, pg8::StaticOrder, PG8_ALIGN, PG8_SP2>(F.lds + RING_OFF, g, S, E);
        if (BOTH(6)) GRID_BAR();
    }
    if (IN(7)) {
        pg8::Gemm g{F.H, F.W2_T, M, DM, FF}; pg8::StaticOrder S; S.init(M, DM, F.G, (int)blockIdx.x);
        pg8::EpiResSq E{F.out, F.out, nullptr, nullptr, F.ROWSQ2, DM};
        pg8::gemm_phase<pg8::EpiResSq, pg8::StaticOrder, PG8_ALIGN, PG8_SP2>(F.lds + RING_OFF, g, S, E);
        if (BOTH(7)) GRID_BAR();
    }
    if (IN(8)) { p8_final_norm(F); }
#undef IN
#undef BOTH
}

extern "C" void kernel_launch(void* const* d_in, const int* in_sizes, int n_in, void* d_out, int out_size, void* d_ws, size_t ws_size, hipStream_t stream) {
    static int grid = 0;
    if (grid == 0) {
        if (n_in != 13 || in_sizes[0] != M * DM || out_size != M * DM || ws_size < WS_END) { fprintf(stderr, "kernel_launch: built for 13 inputs, x and out of %d floats, >= %zu bytes of workspace; got n_in %d, in0 %d, out %d, ws %zu; nothing launched\n", M * DM, (size_t)WS_END, n_in, n_in > 0 ? in_sizes[0] : -1, out_size, ws_size); grid = -1; return; }
        int dev = 0, cus = 0, per_cu = 0;
        if (hipGetDevice(&dev) != hipSuccess || hipDeviceGetAttribute(&cus, hipDeviceAttributeMultiprocessorCount, dev) != hipSuccess) { fprintf(stderr, "kernel_launch: hipGetDevice / hipDeviceGetAttribute failed; nothing launched\n"); grid = -1; return; }
        if (hipFuncSetAttribute((const void*)skel_fwd, hipFuncAttributeMaxDynamicSharedMemorySize, LDS_BYTES) != hipSuccess) { fprintf(stderr, "kernel_launch: hipFuncSetAttribute failed; nothing launched\n"); grid = -1; return; }
        if (hipOccupancyMaxActiveBlocksPerMultiprocessor(&per_cu, (const void*)skel_fwd, NWAVES * 64, LDS_BYTES) != hipSuccess || per_cu < 1)
            fprintf(stderr, "kernel_launch: note: the occupancy query reports %d workgroups per CU\n", per_cu);
        (void)hipGetLastError();
        grid = cus;
    }
    if (grid < 0) return;
    if (hipMemsetAsync((char*)d_ws + WS_CTL, 0, CTL_ZERO_BYTES, stream) != hipSuccess) { fprintf(stderr, "kernel_launch: hipMemsetAsync of the control words failed; nothing launched\n"); return; }
    Args a{};
    for (int i = 0; i < 13; ++i) a.in[i] = (const float*)d_in[i];
    a.out = (float*)d_out; a.ws = (unsigned char*)d_ws;
    for (int li = 0; li < N_LAUNCHES; ++li) {
        a.ph_lo = (N_LAUNCHES == 1) ? 0 : li; a.ph_hi = (N_LAUNCHES == 1) ? N_PHASES : li + 1; a.li = li;
        hipLaunchKernelGGL(skel_fwd, dim3(grid), dim3(NWAVES * 64), LDS_BYTES, stream, a);
        const hipError_t le = hipPeekAtLastError();
        if (le != hipSuccess) { fprintf(stderr, "kernel_launch: launch %d failed: %s\n", li, hipGetErrorName(le)); break; }
    }
}
```

```cpp
#include <hip/hip_runtime.h>
#include <cstdio>
#include <cstdint>
namespace pg8 {
#define PG8_LAS __attribute__((address_space(3)))
typedef unsigned short bf16_t;
typedef short bf16x8 __attribute__((ext_vector_type(8)));
typedef float f32x4 __attribute__((ext_vector_type(4)));
typedef unsigned u32x4 __attribute__((ext_vector_type(4)));
constexpr int BM = 256, BK = 64, HALF = 128, HTB = HALF * BK * 2  , STAGE_BYTES = 8 * HTB, NXCD = 8, WGM = 8;

__host__ __device__ __forceinline__ int lds_byte(int r, int c) { const int st = (r >> 4) * 2 + (c >> 5), rr = r & 15, cc = c & 31, ob = rr * 64 + cc * 2; return st * 1024 + (ob ^ (((ob >> 9) & 1) << 5)); }
__host__ __device__ __forceinline__ void stage_rc(int b, int& R, int& C) { const int st = b / 1024, sb = b % 1024, swz = sb ^ (((sb >> 9) & 1) << 5); R = (st >> 1) * 16 + swz / 64; C = (st & 1) * 32 + (swz % 64) / 2; }
__host__ __device__ __forceinline__ int perm32(int rho) { const int n = rho >> 4, i = rho & 15; return 8 * (i >> 2) + 4 * n + (i & 3); }

struct Unit { int pm, pn; };
struct Gemm { const bf16_t* A; const bf16_t* Bt; int M, N, K; };

struct StaticOrder {
    int nM, nN, nwg, G, c;
    __host__ __device__ void init(int M, int N, int G_, int c_) { nM = M / BM; nN = N / BM; nwg = nM * nN; G = G_; c = c_; }
    __host__ __device__ bool next(int i, Unit& u) const {
        const long L = (long)i * G + c; if (L >= nwg) return false;
        int wgid = (int)L; { const int q = nwg / NXCD, r = nwg % NXCD, xcd = wgid % NXCD, off = wgid / NXCD; wgid = (xcd < r ? xcd * (q + 1) : r * (q + 1) + (xcd - r) * q) + off; }
        const int nig = WGM * nN, gid = wgid / nig, fm = gid * WGM, gsz = (nM - fm) < WGM ? (nM - fm) : WGM;
        u.pm = fm + ((wgid % nig) % gsz); u.pn = (wgid % nig) / gsz; return true;
    }
    __device__ __forceinline__ void a_ready(const Unit&) const {}
    __device__ __forceinline__ void done(const Unit&) const {}
};
__device__ __forceinline__ unsigned cvt_pk_bf16(float lo, float hi) { unsigned r; asm volatile("v_cvt_pk_bf16_f32 %0, %1, %2" : "=v"(r) : "v"(lo), "v"(hi)); return r; }
typedef float f32x2 __attribute__((ext_vector_type(2)));
typedef float f32x2 __attribute__((ext_vector_type(2)));
typedef unsigned u32x2 __attribute__((ext_vector_type(2)));
typedef __bf16 bf16x2_t __attribute__((ext_vector_type(2)));
__device__ __forceinline__ unsigned cvtpk(float lo, float hi) { f32x2 v = {lo, hi}; bf16x2_t b = __builtin_convertvector(v, bf16x2_t); return __builtin_bit_cast(unsigned, b); }

template <int ACT, int RS_MODE> struct EpiBf16Row {
    static constexpr bool PERM = true, AFTER_DRAIN = false;
    bf16_t* O; int ldc; const float* rs; float inv_n, eps;
    __device__ __forceinline__ void operator()(const f32x4 (&acc)[2][2][4][2], const Unit& u, int wr, int wc, int fr, int fq) const {
        const int row0 = u.pm * BM + wr * 64 + fr; const int col0 = u.pn * BM + wc * 32 + 8 * fq;
        float sc[2][4];
#pragma unroll
        for (int ai = 0; ai < 2; ++ai)
#pragma unroll
            for (int m = 0; m < 4; ++m) { float s = rs[row0 + ai * HALF + m * 16]; if (RS_MODE == 1) s = 1.0f / sqrtf(s * inv_n + eps); sc[ai][m] = s; }
#pragma unroll
        for (int ai = 0; ai < 2; ++ai)
#pragma unroll
            for (int m = 0; m < 4; ++m) { bf16_t* rowp = O + (size_t)(row0 + ai * HALF + m * 16) * ldc + col0; const float s = sc[ai][m];
#pragma unroll
                for (int bj = 0; bj < 2; ++bj) { f32x4 v0 = acc[ai][bj][m][0] * s, v1 = acc[ai][bj][m][1] * s;
                    if (ACT == 1) {
#pragma unroll
                        for (int i = 0; i < 4; ++i) { const float a = fmaxf(v0[i], 0.f), b = fmaxf(v1[i], 0.f); v0[i] = a * a; v1[i] = b * b; } }
                    u32x4 w; w.x = cvtpk(v0[0], v0[1]); w.y = cvtpk(v0[2], v0[3]); w.z = cvtpk(v1[0], v1[1]); w.w = cvtpk(v1[2], v1[3]);
                    *(u32x4*)(rowp + bj * HALF) = w; } }
    }
};

struct EpiRes1 {
    static constexpr bool PERM = false, AFTER_DRAIN = false;
    const float* base; bf16_t* xn; const float* g; float* rowsq; int ldc;
    __device__ __forceinline__ void operator()(const f32x4 (&acc)[2][2][4][2], const Unit& u, int wr, int wc, int fr, int fq) const {
        const int col0 = u.pn * BM + wc * 32 + 4 * fq;
        f32x4 gv[2][2];
#pragma unroll
        for (int bj = 0; bj < 2; ++bj)
#pragma unroll
            for (int n = 0; n < 2; ++n) gv[bj][n] = *(const f32x4*)(g + col0 + bj * HALF + n * 16);
#pragma unroll
        for (int ai = 0; ai < 2; ++ai)
#pragma unroll
            for (int m = 0; m < 4; ++m) { const int r = u.pm * BM + ai * HALF + wr * 64 + m * 16 + fr; const size_t off = (size_t)r * ldc + col0; float s = 0.f;
#pragma unroll
                for (int bj = 0; bj < 2; ++bj)
#pragma unroll
                    for (int n = 0; n < 2; ++n) { const f32x4 bs = *(const f32x4*)(base + off + bj * HALF + n * 16); const f32x4 o = bs + acc[ai][bj][m][n];
                        s += (o[0] * o[0] + o[1] * o[1]) + (o[2] * o[2] + o[3] * o[3]);
                        const f32x4 t = o * gv[bj][n]; u32x2 w; w.x = cvtpk(t[0], t[1]); w.y = cvtpk(t[2], t[3]); *(u32x2*)(xn + off + bj * HALF + n * 16) = w; }
                s += __shfl_xor(s, 16); s += __shfl_xor(s, 32);
                if (fq == 0) atomicAdd(rowsq + r, s);
                if (m & 1) asm volatile("" ::: "memory"); }
    }
};
struct EpiRes2 {
    static constexpr bool PERM = false, AFTER_DRAIN = false;
    const bf16_t* xn; const float* g; float* out; float* rowsq; int ldc;
    __device__ __forceinline__ void operator()(const f32x4 (&acc)[2][2][4][2], const Unit& u, int wr, int wc, int fr, int fq) const {
        const int col0 = u.pn * BM + wc * 32 + 4 * fq;
        f32x4 gi[2][2];
#pragma unroll
        for (int bj = 0; bj < 2; ++bj)
#pragma unroll
            for (int n = 0; n < 2; ++n) { const f32x4 gv = *(const f32x4*)(g + col0 + bj * HALF + n * 16); gi[bj][n] = (f32x4){1.0f / gv[0], 1.0f / gv[1], 1.0f / gv[2], 1.0f / gv[3]}; }
#pragma unroll
        for (int ai = 0; ai < 2; ++ai)
#pragma unroll
            for (int m = 0; m < 4; ++m) { const int r = u.pm * BM + ai * HALF + wr * 64 + m * 16 + fr; const size_t off = (size_t)r * ldc + col0; float s = 0.f;
#pragma unroll
                for (int bj = 0; bj < 2; ++bj)
#pragma unroll
                    for (int n = 0; n < 2; ++n) { const u32x2 xb = *(const u32x2*)(xn + off + bj * HALF + n * 16);
                        const f32x4 x1 = (f32x4){__uint_as_float(xb.x << 16), __uint_as_float(xb.x & 0xffff0000u), __uint_as_float(xb.y << 16), __uint_as_float(xb.y & 0xffff0000u)} * gi[bj][n];
                        const f32x4 o = x1 + acc[ai][bj][m][n];
                        *(f32x4*)(out + off + bj * HALF + n * 16) = o; s += (o[0] * o[0] + o[1] * o[1]) + (o[2] * o[2] + o[3] * o[3]); }
                s += __shfl_xor(s, 16); s += __shfl_xor(s, 32);
                if (fq == 0) atomicAdd(rowsq + r, s);
                if (m & 1) asm volatile("" ::: "memory"); }
    }
};

template <class Epi, class Sched, bool ALIGN_EPI = false, bool SP2 = false>
__device__ __forceinline__ void gemm_phase(PG8_LAS unsigned char* lds, const Gemm g, const Sched& S, const Epi& E) {
    const int tid = threadIdx.x, wid = __builtin_amdgcn_readfirstlane(tid >> 6), lane = tid & 63, wr = wid >> 2, wc = wid & 3, fr = lane & 15, fq = lane >> 4;
    const int K = g.K, nt = K / BK;
    unsigned voffA[2], voffB[2];
#pragma unroll
    for (int i = 0; i < 2; ++i) { int R, C; stage_rc(tid * 16 + i * 8192, R, C); const int Rb = Epi::PERM ? ((R & ~31) + perm32(R & 31)) : R;
        voffA[i] = (unsigned)(R * K + C) * 2u; voffB[i] = (unsigned)(Rb * K + C) * 2u; }
    const size_t kstep = (size_t)(BK * 2);
    const size_t hstep = (size_t)HALF * K * 2;
    const size_t tstep = 2 * hstep;
    const unsigned ldsw = (unsigned)wid * 1024u;
    const int aoff = lds_byte(wr * 64 + fr, fq * 8), boff = lds_byte(wc * 32 + fr, fq * 8);
#define PG8_SA(b, h) (((b) * 2 + (h)) * HTB)
#define PG8_SB(b, h) ((4 + (b) * 2 + (h)) * HTB)
#define PG8_STAGE(bufoff, gbase, voff) do { _Pragma("unroll") for (int _i = 0; _i < 2; ++_i) \
        __builtin_amdgcn_global_load_lds((const unsigned*)((const char*)(gbase) + (voff)[_i]), (PG8_LAS unsigned*)(lds + (bufoff) + ldsw + _i * 8192), 16, 0, 0); } while (0)
#define PG8_LDA(dst, b, h) do { _Pragma("unroll") for (int m = 0; m < 4; ++m) _Pragma("unroll") for (int k = 0; k < 2; ++k) dst[m][k] = *(const PG8_LAS bf16x8*)(lds + PG8_SA(b, h) + aoff + m * 2048 + k * 1024); } while (0)
#define PG8_LDB(dst, b, h) do { _Pragma("unroll") for (int n = 0; n < 2; ++n) _Pragma("unroll") for (int k = 0; k < 2; ++k) dst[n][k] = *(const PG8_LAS bf16x8*)(lds + PG8_SB(b, h) + boff + n * 2048 + k * 1024); } while (0)
#define PG8_MMA(ai, bj, At, Bt) do { __builtin_amdgcn_s_setprio(1); _Pragma("unroll") for (int m = 0; m < 4; ++m) _Pragma("unroll") for (int n = 0; n < 2; ++n) _Pragma("unroll") for (int k = 0; k < 2; ++k) \
        acc[ai][bj][m][n] = __builtin_amdgcn_mfma_f32_16x16x32_bf16(Bt[n][k], At[m][k], acc[ai][bj][m][n], 0, 0, 0); __builtin_amdgcn_s_setprio(0); } while (0)
#define PG8_WAIT_V(n) asm volatile("s_waitcnt vmcnt(" #n ")" ::: "memory")
#define PG8_WAIT_L(n) asm volatile("s_waitcnt lgkmcnt(" #n ")" ::: "memory")
#define PG8_BAR __builtin_amdgcn_s_barrier()
#define PG8_SCHED __builtin_amdgcn_sched_barrier(0)
    Unit cur, nxt; int ui = 0;
    if (!S.next(0, cur)) return;
    f32x4 acc[2][2][4][2];
#pragma unroll
    for (int a = 0; a < 2; ++a)
#pragma unroll
        for (int b = 0; b < 2; ++b)
#pragma unroll
            for (int m = 0; m < 4; ++m)
#pragma unroll
                for (int n = 0; n < 2; ++n) acc[a][b][m][n] = (f32x4){0.f, 0.f, 0.f, 0.f};
    bf16x8 At[4][2], B0[2][2], B1[2][2];
    const char* cA = (const char*)g.A + (size_t)cur.pm * tstep; const char* cB = (const char*)g.Bt + (size_t)cur.pn * tstep;
    S.a_ready(cur);
    if constexpr (SP2) {
        PG8_STAGE(PG8_SB(0, 0), cB, voffB); PG8_STAGE(PG8_SB(0, 1), cB + hstep, voffB); PG8_STAGE(PG8_SA(0, 0), cA, voffA); PG8_STAGE(PG8_SA(0, 1), cA + hstep, voffA);
        if (wr == 1) PG8_BAR;
        PG8_WAIT_V(2); PG8_BAR;
        PG8_STAGE(PG8_SB(1, 0), cB + kstep, voffB); PG8_STAGE(PG8_SA(1, 0), cA + kstep, voffA); PG8_STAGE(PG8_SB(1, 1), cB + hstep + kstep, voffB);
        PG8_WAIT_V(6); PG8_BAR;
    } else {
        PG8_STAGE(PG8_SB(0, 0), cB, voffB); PG8_STAGE(PG8_SA(0, 0), cA, voffA); PG8_STAGE(PG8_SB(0, 1), cB + hstep, voffB); PG8_STAGE(PG8_SA(0, 1), cA + hstep, voffA);
        if (wr == 1) PG8_BAR;
        PG8_WAIT_V(4); PG8_BAR;
        PG8_STAGE(PG8_SB(1, 0), cB + kstep, voffB); PG8_STAGE(PG8_SA(1, 0), cA + kstep, voffA); PG8_STAGE(PG8_SB(1, 1), cB + hstep + kstep, voffB);
        PG8_WAIT_V(6); PG8_BAR;
    }
    for (;;) {
        const bool has_next = S.next(ui + 1, nxt);
        const char* nA = has_next ? (const char*)g.A + (size_t)nxt.pm * tstep : cA; const char* nB = has_next ? (const char*)g.Bt + (size_t)nxt.pn * tstep : cB;
        for (int t = 0; t < nt; t += 2) {
            const bool last = (t == nt - 2);
            const char* a1 = cA + (size_t)(t + 1) * kstep;
            const char* a2 = last ? nA : cA + (size_t)(t + 2) * kstep; const char* b2 = last ? nB : cB + (size_t)(t + 2) * kstep;
            const char* a3 = a2 + kstep; const char* b3 = b2 + kstep;
            if (last && has_next) S.a_ready(nxt);
            if constexpr (SP2) {
            PG8_LDB(B0, 0, 0); PG8_LDB(B1, 0, 1); PG8_SCHED; PG8_LDA(At, 0, 0); PG8_STAGE(PG8_SA(1, 1), a1 + hstep, voffA);
            PG8_WAIT_V(8); PG8_WAIT_L(0); PG8_BAR; PG8_MMA(0, 0, At, B0); PG8_MMA(0, 1, At, B1); PG8_BAR; PG8_SCHED;
            PG8_LDA(At, 0, 1); PG8_STAGE(PG8_SB(0, 0), b2, voffB); PG8_STAGE(PG8_SB(0, 1), b2 + hstep, voffB); PG8_STAGE(PG8_SA(0, 0), a2, voffA);
            PG8_WAIT_V(8); PG8_WAIT_L(0); PG8_BAR; PG8_MMA(1, 0, At, B0); PG8_MMA(1, 1, At, B1); PG8_BAR; PG8_SCHED;
            PG8_LDB(B0, 1, 0); PG8_LDB(B1, 1, 1); PG8_SCHED; PG8_LDA(At, 1, 0); PG8_STAGE(PG8_SA(0, 1), a2 + hstep, voffA);
            PG8_WAIT_V(8); PG8_WAIT_L(0); PG8_BAR; PG8_MMA(0, 0, At, B0); PG8_MMA(0, 1, At, B1); PG8_BAR; PG8_SCHED;
            PG8_LDA(At, 1, 1); PG8_STAGE(PG8_SB(1, 0), b3, voffB); PG8_STAGE(PG8_SB(1, 1), b3 + hstep, voffB); PG8_STAGE(PG8_SA(1, 0), a3, voffA);
            PG8_WAIT_V(8); PG8_WAIT_L(0); PG8_BAR; PG8_MMA(1, 0, At, B0); PG8_MMA(1, 1, At, B1); PG8_BAR; PG8_SCHED;
            } else {
            PG8_LDB(B0, 0, 0); PG8_SCHED; PG8_LDA(At, 0, 0); PG8_STAGE(PG8_SA(1, 1), a1 + hstep, voffA);
            PG8_WAIT_L(8); PG8_BAR; PG8_WAIT_L(0); PG8_MMA(0, 0, At, B0); PG8_BAR; PG8_SCHED;
            PG8_LDB(B1, 0, 1); PG8_STAGE(PG8_SB(0, 0), b2, voffB);
            PG8_BAR; PG8_WAIT_L(0); PG8_MMA(0, 1, At, B1); PG8_BAR;
            PG8_LDA(At, 0, 1); PG8_STAGE(PG8_SA(0, 0), a2, voffA);
            PG8_BAR; PG8_WAIT_L(0); PG8_MMA(1, 0, At, B0); PG8_BAR; PG8_SCHED;
            PG8_STAGE(PG8_SB(0, 1), b2 + hstep, voffB);
            PG8_WAIT_V(6); PG8_BAR; PG8_MMA(1, 1, At, B1); PG8_BAR;
            PG8_LDB(B0, 1, 0); PG8_SCHED; PG8_LDA(At, 1, 0); PG8_STAGE(PG8_SA(0, 1), a2 + hstep, voffA);
            PG8_WAIT_L(8); PG8_BAR; PG8_WAIT_L(0); PG8_MMA(0, 0, At, B0); PG8_BAR; PG8_SCHED;
            PG8_LDB(B1, 1, 1); PG8_STAGE(PG8_SB(1, 0), b3, voffB);
            PG8_BAR; PG8_WAIT_L(0); PG8_MMA(0, 1, At, B1); PG8_BAR;
            PG8_LDA(At, 1, 1); PG8_STAGE(PG8_SA(1, 0), a3, voffA);
            PG8_BAR; PG8_WAIT_L(0); PG8_MMA(1, 0, At, B0); PG8_BAR; PG8_SCHED;
            PG8_STAGE(PG8_SB(1, 1), b3 + hstep, voffB);
            PG8_WAIT_V(6); PG8_BAR; PG8_MMA(1, 1, At, B1); PG8_BAR;
            }
        }
        if constexpr (ALIGN_EPI) { if (wr == 0) PG8_BAR; }
        if constexpr (!Epi::AFTER_DRAIN) { E(acc, cur, wr, wc, fr, fq); S.done(cur); }
        if (!has_next) break;
#pragma unroll
        for (int a = 0; a < 2; ++a)
#pragma unroll
            for (int b = 0; b < 2; ++b)
#pragma unroll
                for (int m = 0; m < 4; ++m)
#pragma unroll
                    for (int n = 0; n < 2; ++n) acc[a][b][m][n] = (f32x4){0.f, 0.f, 0.f, 0.f};
        cur = nxt; cA = nA; cB = nB; ++ui;
        if constexpr (ALIGN_EPI) { if (wr == 1) PG8_BAR; }
    }
    PG8_WAIT_V(0);
    if constexpr (!ALIGN_EPI) { if (wr == 0) PG8_BAR; }
    PG8_BAR;
    if constexpr (Epi::AFTER_DRAIN) { E.fused(acc, cur, wr, wc, fr, fq, lds, wid, lane); S.done(cur); }
#undef PG8_SA
#undef PG8_SB
#undef PG8_STAGE
#undef PG8_LDA
#undef PG8_LDB
#undef PG8_MMA
#undef PG8_WAIT_V
#undef PG8_WAIT_L
#undef PG8_BAR
#undef PG8_SCHED
}
}
#ifndef PG8_SP2
#define PG8_SP2 true
#endif
#ifndef PG8_ALIGN
#define PG8_ALIGN true
#endif

constexpr int NWAVES = 8;
#ifndef MK_N_LAUNCHES
#define MK_N_LAUNCHES 1
#endif
constexpr int N_PHASES = 9;
constexpr int N_LAUNCHES = MK_N_LAUNCHES;
static_assert(N_LAUNCHES == 1 || N_LAUNCHES == N_PHASES, "MK_N_LAUNCHES is 1 or N_PHASES");

constexpr int BATCH = 2, SEQ = 8192, DM = 2048, M = BATCH * SEQ, FF = 8192;
constexpr int D_IN = 6160, NZ = 6144;
constexpr int ZCB = 0, ZCC = 1024, ZCH = 2048, ZQ = 3072, ZK = 3584, ZV = 4096, ZOG = 5120;
constexpr int NCHUNK = M / 64;
constexpr float EPS = 1e-6f;
constexpr float QSCALE = 0.08838834764831845f;

constexpr size_t MiB = 1u << 20;
constexpr size_t WS_CTL = 0, CTL_ZERO_BYTES = 1 * MiB;
constexpr size_t WS_WIN = 2 * MiB, WS_WOUT = 26 * MiB, WS_W1 = 34 * MiB, WS_W2 = 66 * MiB;
constexpr size_t WS_MISC = 98 * MiB;
constexpr size_t WS_ALOW = WS_MISC, WS_RSTD1 = WS_MISC + 1 * MiB, WS_DEC = WS_RSTD1 + 65536, WS_DRUN = WS_DEC + 524288;
constexpr size_t WS_XN = 100 * MiB;
constexpr size_t WS_RUNAGG = WS_XN, WS_SSTART = WS_XN + 32 * MiB;
constexpr size_t WS_Z = 164 * MiB;
constexpr size_t WS_Y = 356 * MiB;
constexpr size_t WS_H = 164 * MiB;
constexpr size_t WS_KDECT = 420 * MiB;
constexpr size_t WS_END = 436 * MiB;
static_assert(WS_W2 + (size_t)DM * FF * 2 <= WS_MISC && WS_DRUN + 131072 <= WS_XN && WS_XN + (size_t)M * DM * 2 <= WS_Z && WS_Z + (size_t)M * NZ * 2 <= WS_Y && WS_Y + (size_t)M * DM * 2 <= WS_KDECT && WS_H + (size_t)M * FF * 2 <= WS_KDECT, "d_ws map");
constexpr int CW_TMO = 0, CW_CODE = 1;
constexpr int CW_BAR = 4096;
constexpr int CW_ROWSQ1 = 65536, CW_ROWSQ2 = 65536 + M;
static_assert((CW_ROWSQ2 + M) * 4 <= (int)CTL_ZERO_BYTES, "CTL words inside the memset region");

constexpr int RING_OFF = 0, RING_BYTES = 131072;
constexpr int PHASE_LDS_MAX = 143360;
constexpr int LDSCTL_OFF = PHASE_LDS_MAX, MISC_OFF = LDSCTL_OFF + 320;
constexpr int LDS_BYTES = 147456;
static_assert(MISC_OFF + 128 <= LDS_BYTES, "LDS map");

#define GAS __attribute__((address_space(1)))
#define LAS __attribute__((address_space(3)))
typedef unsigned short bf16;
typedef unsigned v4u __attribute__((ext_vector_type(4)));
typedef unsigned v2u __attribute__((ext_vector_type(2)));
typedef float f32x4 __attribute__((ext_vector_type(4)));
typedef float f32x2 __attribute__((ext_vector_type(2)));
typedef float f32x16 __attribute__((ext_vector_type(16)));
typedef short bf16x8 __attribute__((ext_vector_type(8)));
typedef short bf16x4 __attribute__((ext_vector_type(4)));
typedef GAS unsigned gu32;
typedef GAS unsigned long long gu64;
#define RLX_AGENT __ATOMIC_RELAXED, __HIP_MEMORY_SCOPE_AGENT
#define LDS_WAIT() asm volatile("s_waitcnt lgkmcnt(0)" ::: "memory")
#define VM_WAIT() asm volatile("s_waitcnt vmcnt(0)" ::: "memory")
using pg8::cvtpk;
__device__ __forceinline__ float bflo(unsigned p) { return __uint_as_float(p << 16); }
__device__ __forceinline__ float bfhi(unsigned p) { return __uint_as_float(p & 0xffff0000u); }
__device__ __forceinline__ int crow(int reg, int hh) { return (reg & 3) + 8 * (reg >> 2) + 4 * hh; }
#define MFMA32(a, b, c) __builtin_amdgcn_mfma_f32_32x32x16_bf16((a), (b), (c), 0, 0, 0)
#define MFMA16(a, b, c) __builtin_amdgcn_mfma_f32_16x16x32_bf16((a), (b), (c), 0, 0, 0)

#define XB_TMO      128
#define XB_XCNT(j)  (256  + 64 * (j))
#define XB_XSUB(j)  (1280 + 64 * (j))
#define XB_XGEN(j)  (2304 + 64 * (j))
#define XB_TOP      3328
#define XB_TOPGEN   3392
#define XCD_BAR_WORDS 3456
#define XB_SPIN_CAP (1u << 18)

__device__ __forceinline__ unsigned xb_ld(unsigned* p)              { return __hip_atomic_load(p, __ATOMIC_RELAXED, __HIP_MEMORY_SCOPE_AGENT); }
__device__ __forceinline__ unsigned xb_add(unsigned* p, unsigned v) { return __hip_atomic_fetch_add(p, v, __ATOMIC_RELAXED, __HIP_MEMORY_SCOPE_AGENT); }
__device__ __forceinline__ unsigned xb_xcc_id() { return (unsigned)__builtin_amdgcn_s_getreg((3 << 11) | 20) & 0xFu; }
#define XB_SPIN(cond, bar) do { unsigned _sp = 0; while (cond) { __builtin_amdgcn_s_sleep(1); \
    if ((++_sp & 255u) == 0u) { if (xb_ld(&(bar)[XB_TMO])) break; if (_sp > XB_SPIN_CAP) { atomicAdd(&(bar)[XB_TMO], 1u); break; } } } } while (0)

struct XcdBarrier {
    unsigned* bar; unsigned x;
    volatile LAS unsigned* st;
};

__device__ __forceinline__ XcdBarrier xcd_barrier_post(unsigned* bar, volatile LAS unsigned* st) {
    XcdBarrier b; b.bar = bar; b.x = xb_xcc_id(); b.st = st;
    if (threadIdx.x == 0) (void)xb_add(&bar[XB_XCNT(b.x)], 1u);
    return b;
}
__device__ __forceinline__ void xcd_barrier_complete(unsigned* bar, unsigned x, unsigned& nloc, unsigned& nx) {
    const unsigned G = gridDim.x * gridDim.y * gridDim.z;
    unsigned sum, cnt, mine, sp = 0u;
    for (;;) {
        sum = 0u; cnt = 0u; mine = 0u;
#pragma unroll
        for (unsigned j = 0; j < 16; ++j) { const unsigned c = xb_ld(&bar[XB_XCNT(j)]); sum += c; cnt += (c > 0u) ? 1u : 0u; mine = (j == x) ? c : mine; }
        if (sum == G) break;
        __builtin_amdgcn_s_sleep(1);
        if ((++sp & 255u) == 0u) { if (xb_ld(&bar[XB_TMO])) break; if (sp > XB_SPIN_CAP) { atomicAdd(&bar[XB_TMO], 1u); break; } }
    }
    nloc = mine > 0u ? mine : 1u; nx = cnt > 0u ? cnt : 1u;
}

__device__ __forceinline__ void xcd_barrier(const XcdBarrier& b) {
    asm volatile("s_waitcnt vmcnt(0)" ::: "memory");
    __syncthreads();
    if (threadIdx.x == 0) {
        unsigned* bar = b.bar;
        __builtin_amdgcn_s_waitcnt(0);
        unsigned nloc = b.st[0], nx = b.st[1];
        if (nloc == 0u) { xcd_barrier_complete(bar, b.x, nloc, nx); b.st[0] = nloc; b.st[1] = nx; }
        const unsigned old = xb_add(&bar[XB_XSUB(b.x)], 1u);
        const unsigned gen = old / nloc;
        if (old + 1u == (gen + 1u) * nloc) {
            __builtin_amdgcn_fence(__ATOMIC_RELEASE, "agent");
            asm volatile("s_waitcnt vmcnt(0)" ::: "memory");
            const unsigned og = xb_add(&bar[XB_TOP], 1u);
            const unsigned tg = og / nx;
            if (og + 1u == (tg + 1u) * nx) xb_add(&bar[XB_TOPGEN], 1u);
            else XB_SPIN(xb_ld(&bar[XB_TOPGEN]) == tg, bar);
            __builtin_amdgcn_fence(__ATOMIC_ACQUIRE, "agent");
            xb_add(&bar[XB_XGEN(b.x)], 1u);
            asm volatile("s_waitcnt vmcnt(0)" ::: "memory");
        } else {
            XB_SPIN(xb_ld(&bar[XB_XGEN(b.x)]) == gen, bar);
            __builtin_amdgcn_fence(__ATOMIC_ACQUIRE, "agent");
            asm volatile("s_waitcnt vmcnt(0)" ::: "memory");
        }
    }
    __syncthreads();
}
struct Frame {
    LAS unsigned char* lds;
    volatile LAS unsigned* MISC;
    gu32* ctl;
    int tid, lane, wave;
    int vcu, G;
    const float *x, *g1, *w_in, *wgate, *bgate, *conv_w, *conv_g, *gla_g, *w_out, *g2, *w1, *w2, *gf;
    float* out;
    bf16 *WIN_T, *WOUT_T, *W1_T, *W2_T;
    bf16 *XN, *Z, *Y, *H, *KDECT;
    float *ALOW, *RSTD1, *DEC, *DRUN, *RUNAGG, *SSTART, *ROWSQ1, *ROWSQ2;
};

__device__ __forceinline__ void p0_transpose_item(const float* W, int ldw, int K, int nblk, bf16* WT, LAS float* scr, int item, int lane) {
    const int kb = item / nblk, nb = item % nblk, k0 = 64 * kb, n0 = 32 * nb;
    const float* src = W + (size_t)(k0 + (lane >> 3)) * ldw + n0 + 4 * (lane & 7);
    f32x4 v[8];
#pragma unroll
    for (int i = 0; i < 8; ++i) v[i] = *(const GAS f32x4*)(src + (size_t)(8 * i) * ldw);
#pragma unroll
    for (int i = 0; i < 8; ++i) { LAS float* d = scr + ((lane >> 3) + 8 * i) * 33 + 4 * (lane & 7); d[0] = v[i][0]; d[1] = v[i][1]; d[2] = v[i][2]; d[3] = v[i][3]; }
    LDS_WAIT(); asm volatile("" ::: "memory");
    const int c = lane & 7;
#pragma unroll
    for (int j = 0; j < 4; ++j) { const int n = (lane >> 3) + 8 * j; const LAS float* s = scr + (8 * c) * 33 + n;
        v4u o; o.x = cvtpk(s[0 * 33], s[1 * 33]); o.y = cvtpk(s[2 * 33], s[3 * 33]); o.z = cvtpk(s[4 * 33], s[5 * 33]); o.w = cvtpk(s[6 * 33], s[7 * 33]);
        *(GAS v4u*)(WT + (size_t)(n0 + n) * K + k0 + 8 * c) = o; }
    LDS_WAIT(); asm volatile("" ::: "memory");
}
__device__ __forceinline__ void p0_x_item(Frame& F, int item, const LAS v4u* WA, const LAS float* G1) {
    const int lane = F.lane, fr = lane & 15, fq = lane >> 4;
    const int row = item * 16 + fr;
    const float* xr = F.x + (size_t)row * DM + 16 * fq;
    bf16* xo = F.XN + (size_t)row * DM + 16 * fq;
    const LAS float* gp = G1 + 16 * fq;
    f32x4 acc = {0.f, 0.f, 0.f, 0.f}; float ss = 0.f;
#pragma unroll 4
    for (int sp = 0; sp < 32; ++sp) {
        f32x4 xv[4], p[4];
#pragma unroll
        for (int i = 0; i < 4; ++i) xv[i] = *(const f32x4*)(xr + 64 * sp + 4 * i);
#pragma unroll
        for (int i = 0; i < 4; ++i) { const f32x4 gv = *(const LAS f32x4*)(gp + 64 * sp + 4 * i); ss += (xv[i][0] * xv[i][0] + xv[i][1] * xv[i][1]) + (xv[i][2] * xv[i][2] + xv[i][3] * xv[i][3]); p[i] = xv[i] * gv; }
        v4u a0, a1;
        a0.x = cvtpk(p[0][0], p[0][1]); a0.y = cvtpk(p[0][2], p[0][3]); a0.z = cvtpk(p[1][0], p[1][1]); a0.w = cvtpk(p[1][2], p[1][3]);
        a1.x = cvtpk(p[2][0], p[2][1]); a1.y = cvtpk(p[2][2], p[2][3]); a1.z = cvtpk(p[3][0], p[3][1]); a1.w = cvtpk(p[3][2], p[3][3]);
        *(GAS v4u*)(xo + 64 * sp) = a0; *(GAS v4u*)(xo + 64 * sp + 8) = a1;
        const v4u b0 = WA[(2 * sp) * 64 + lane], b1 = WA[(2 * sp + 1) * 64 + lane];
        acc = MFMA16(__builtin_bit_cast(bf16x8, a0), __builtin_bit_cast(bf16x8, b0), acc);
        acc = MFMA16(__builtin_bit_cast(bf16x8, a1), __builtin_bit_cast(bf16x8, b1), acc);
    }
    ss += __shfl_xor(ss, 16); ss += __shfl_xor(ss, 32);
    const float rstd = 1.0f / sqrtf(ss * (1.0f / DM) + EPS);
    if (fq == 0) F.RSTD1[row] = rstd;
#pragma unroll
    for (int reg = 0; reg < 4; ++reg) { const float rr = __shfl(rstd, 4 * fq + reg); F.ALOW[(size_t)(item * 16 + 4 * fq + reg) * 16 + fr] = acc[reg] * rr; }
}
__device__ __forceinline__ void p0_prologue(Frame& F) {
    LAS v4u* WA = (LAS v4u*)(F.lds);
    LAS float* G1 = (LAS float*)(F.lds + 65536);
    LAS float* scr = (LAS float*)(F.lds + 73728 + F.wave * 8448);
    static_assert(73728 + NWAVES * 8448 <= PHASE_LDS_MAX, "P0 LDS");
    for (int idx = F.tid; idx < 4096; idx += NWAVES * 64) {
        const int sp = idx >> 6, l = idx & 63, fq = l >> 4, fr = l & 15;
        const int kb = 64 * (sp >> 1) + 16 * fq + 8 * (sp & 1);
        const float* src = F.w_in + (size_t)kb * D_IN + NZ + fr;
        float v[8];
#pragma unroll
        for (int j = 0; j < 8; ++j) v[j] = src[(size_t)j * D_IN];
        v4u o; o.x = cvtpk(v[0], v[1]); o.y = cvtpk(v[2], v[3]); o.z = cvtpk(v[4], v[5]); o.w = cvtpk(v[6], v[7]);
        WA[idx] = o;
    }
    for (int i = F.tid; i < DM; i += NWAVES * 64) G1[i] = F.g1[i];
    __syncthreads();
    for (int it = F.wave * F.G + F.vcu; it < M / 16; it += NWAVES * F.G) p0_x_item(F, it, WA, G1);
    constexpr int I_IN = (DM / 64) * (NZ / 32), I_OUT = (DM / 64) * (DM / 32), I_1 = (DM / 64) * (FF / 32), I_2 = (FF / 64) * (DM / 32);
    constexpr int NITEMS = I_IN + I_OUT + I_1 + I_2;
    const int s_begin = F.wave < 4 ? 4 * F.wave : 16 + 20 * (F.wave - 4), s_end = F.wave < 4 ? s_begin + 4 : s_begin + 20;
    for (int sl = s_begin; sl < s_end; ++sl)
        for (int it = sl * F.G + F.vcu; it < NITEMS; it += 96 * F.G) {
            int r = it;
            if (r < I_IN) { p0_transpose_item(F.w_in, D_IN, DM, NZ / 32, F.WIN_T, scr, r, F.lane); continue; } r -= I_IN;
            if (r < I_OUT) { p0_transpose_item(F.w_out, DM, DM, DM / 32, F.WOUT_T, scr, r, F.lane); continue; } r -= I_OUT;
            if (r < I_1) { p0_transpose_item(F.w1, FF, DM, FF / 32, F.W1_T, scr, r, F.lane); continue; } r -= I_1;
            p0_transpose_item(F.w2, DM, FF, DM / 32, F.W2_T, scr, r, F.lane);
        }
}

__device__ __forceinline__ void p2_gate_runagg(Frame& F) {
    LAS float* AL = (LAS float*)(F.lds);
    LAS unsigned char* KDT = F.lds + 16384;
    LAS unsigned char* VT = F.lds + 16384 + 73728;
    LAS float* DECS = (LAS float*)(F.lds + 16384 + 73728 + 33792);
    const int tid = F.tid, lane = F.lane, w = F.wave, l31 = lane & 31, hh = lane >> 5;
    for (int uid = blockIdx.x; uid < 256; uid += F.G) {
        const int b = uid >> 7, r = (uid >> 2) & 31, h = uid & 3;
        const int row0 = b * SEQ + r * 256;
        __syncthreads();
        { const GAS f32x4* src = (const GAS f32x4*)(F.ALOW + (size_t)row0 * 16); for (int i = tid; i < 1024; i += NWAVES * 64) ((LAS f32x4*)AL)[i] = src[i]; }
        __syncthreads();
        {   const int j = tid >> 7, col = tid & 127, gcol = h * 128 + col;
            float wg[16];
#pragma unroll
            for (int rr = 0; rr < 16; ++rr) wg[rr] = F.wgate[rr * 512 + gcol];
            const float bgv = F.bgate[gcol];
            const bf16* kp = F.Z + (size_t)(row0 + j * 64) * NZ + ZK + gcol;
            bf16* kdt_g = F.KDECT + ((size_t)((b * 128 + r * 4 + j) * 4 + h) * 128 + col) * 64;
            float rs = 0.f;
            for (int t8 = 7; t8 >= 0; --t8) {
                float kd[8];
#pragma unroll
                for (int tt = 7; tt >= 0; --tt) {
                    const int t = t8 * 8 + tt;
                    const LAS f32x4* ap = (const LAS f32x4*)(AL + (j * 64 + t) * 16);
                    const f32x4 a0 = ap[0], a1 = ap[1], a2 = ap[2], a3 = ap[3];
                    float pre = bgv;
                    pre += a0[0] * wg[0] + a0[1] * wg[1] + a0[2] * wg[2] + a0[3] * wg[3];
                    pre += a1[0] * wg[4] + a1[1] * wg[5] + a1[2] * wg[6] + a1[3] * wg[7];
                    pre += a2[0] * wg[8] + a2[1] * wg[9] + a2[2] * wg[10] + a2[3] * wg[11];
                    pre += a3[0] * wg[12] + a3[1] * wg[13] + a3[2] * wg[14] + a3[3] * wg[15];
                    const float la = (fminf(pre, 0.f) - __logf(1.f + __expf(-fabsf(pre)))) * (1.0f / 16.0f);
                    const float kv = __uint_as_float((unsigned)kp[(size_t)t * NZ] << 16);
                    kd[tt] = kv * __expf(rs);
                    rs += la;
                }
                v4u o; o.x = cvtpk(kd[0], kd[1]); o.y = cvtpk(kd[2], kd[3]); o.z = cvtpk(kd[4], kd[5]); o.w = cvtpk(kd[6], kd[7]);
                *(LAS v4u*)(KDT + (j * 128 + col) * 144 + t8 * 16) = o;
                *(GAS v4u*)(kdt_g + t8 * 8) = o;
            }
            const float dec = __expf(rs);
            DECS[j * 128 + col] = dec;
            F.DEC[(size_t)(b * 128 + r * 4 + j) * 512 + gcol] = dec;
        }
        __syncthreads();
        if (tid < 128) F.DRUN[(size_t)uid * 128 + tid] = (DECS[tid] * DECS[128 + tid]) * (DECS[256 + tid] * DECS[384 + tid]);
        f32x16 S[4];
#pragma unroll
        for (int kb = 0; kb < 4; ++kb)
#pragma unroll
            for (int reg = 0; reg < 16; ++reg) S[kb][reg] = 0.f;
        for (int j = 0; j < 4; ++j) {
            if (j) __syncthreads();
            for (int i = tid; i < 2048; i += NWAVES * 64) { const int t = i >> 5, c16 = i & 31;
                const v4u v = *(const GAS v4u*)(F.Z + (size_t)(row0 + j * 64 + t) * NZ + ZV + h * 256 + c16 * 8); *(LAS v4u*)(VT + t * 528 + c16 * 16) = v; }
            __syncthreads();
            if (j) {
#pragma unroll
                for (int kb = 0; kb < 4; ++kb)
#pragma unroll
                    for (int reg = 0; reg < 16; ++reg) S[kb][reg] *= DECS[j * 128 + 32 * kb + crow(reg, hh)];
            }
#pragma unroll
            for (int s = 0; s < 4; ++s) {
                bf16x8 bfrag;
#pragma unroll
                for (int jj = 0; jj < 8; ++jj) bfrag[jj] = *(const LAS short*)(VT + (16 * s + 8 * hh + jj) * 528 + (32 * w + l31) * 2);
#pragma unroll
                for (int kb = 0; kb < 4; ++kb) { const bf16x8 afrag = *(const LAS bf16x8*)(KDT + (j * 128 + 32 * kb + l31) * 144 + (16 * s + 8 * hh) * 2); S[kb] = MFMA32(afrag, bfrag, S[kb]); }
            }
        }
        float* dst = F.RUNAGG + ((size_t)uid * 8 + w) * 4096 + lane;
#pragma unroll
        for (int kb = 0; kb < 4; ++kb)
#pragma unroll
            for (int reg = 0; reg < 16; ++reg) dst[kb * 1024 + reg * 64] = S[kb][reg];
    }
}

__device__ __forceinline__ void p3_scan(Frame& F) {
    const int nthr = F.G * NWAVES * 64;
    for (int e = blockIdx.x * NWAVES * 64 + F.tid; e < 131072; e += nthr) {
        const int bh = e >> 14, idx = (e & 16383) * 2, b = bh >> 2, h = bh & 3;
        const int kb = (idx >> 10) & 3, reg = (idx >> 6) & 15, ln = idx & 63, k = 32 * kb + crow(reg, ln >> 5);
        float sx = 0.f, sy = 0.f;
#pragma unroll 8
        for (int r = 0; r < 32; ++r) {
            const size_t uid = (size_t)(b * 32 + r) * 4 + h, off = uid * 32768 + idx;
            *(GAS f32x2*)(F.SSTART + off) = (f32x2){sx, sy};
            const float d = F.DRUN[uid * 128 + k]; const f32x2 a = *(const GAS f32x2*)(F.RUNAGG + off);
            sx = d * sx + a[0]; sy = d * sy + a[1];
        }
    }
}
__device__ __forceinline__ float wave_sum(float v) {
#pragma unroll
    for (int o = 1; o < 64; o <<= 1) v += __shfl_xor(v, o);
    return v;
}
__device__ __forceinline__ void bf8_to_f32(const v4u p, float (&f)[8]) {
    f[0] = bflo(p.x); f[1] = bfhi(p.x); f[2] = bflo(p.y); f[3] = bfhi(p.y); f[4] = bflo(p.z); f[5] = bfhi(p.z); f[6] = bflo(p.w); f[7] = bfhi(p.w);
}
__device__ __forceinline__ void p3_conv(Frame& F) {
    const int ch = 512 * (F.wave & 1) + 8 * F.lane;
    float w0[8], w1[8], w2[8], gg[8];
#pragma unroll
    for (int i = 0; i < 8; ++i) { w0[i] = F.conv_w[(ch + i) * 3 + 0]; w1[i] = F.conv_w[(ch + i) * 3 + 1]; w2[i] = F.conv_w[(ch + i) * 3 + 2]; gg[i] = F.conv_g[ch + i]; }
    for (int c = blockIdx.x; c < NCHUNK; c += F.G) {
        const int row0 = c * 64 + 16 * (F.wave >> 1);
        float um2[8], um1[8];
        if ((row0 & (SEQ - 1)) == 0) {
#pragma unroll
            for (int i = 0; i < 8; ++i) { um2[i] = 0.f; um1[i] = 0.f; }
        } else {
            const bf16* z2 = F.Z + (size_t)(row0 - 2) * NZ; const bf16* z1 = F.Z + (size_t)(row0 - 1) * NZ;
            float a[8], b[8];
            bf8_to_f32(*(const GAS v4u*)(z2 + ZCC + ch), a); bf8_to_f32(*(const GAS v4u*)(z2 + ZCH + ch), b);
#pragma unroll
            for (int i = 0; i < 8; ++i) um2[i] = a[i] * b[i];
            bf8_to_f32(*(const GAS v4u*)(z1 + ZCC + ch), a); bf8_to_f32(*(const GAS v4u*)(z1 + ZCH + ch), b);
#pragma unroll
            for (int i = 0; i < 8; ++i) um1[i] = a[i] * b[i];
        }
#pragma unroll 4
        for (int t = 0; t < 16; ++t) {
            const bf16* zr = F.Z + (size_t)(row0 + t) * NZ;
            float cb[8], cc[8], chv[8], y[8];
            bf8_to_f32(*(const GAS v4u*)(zr + ZCB + ch), cb); bf8_to_f32(*(const GAS v4u*)(zr + ZCC + ch), cc); bf8_to_f32(*(const GAS v4u*)(zr + ZCH + ch), chv);
            float ss = 0.f;
#pragma unroll
            for (int i = 0; i < 8; ++i) { const float u = cc[i] * chv[i]; y[i] = cb[i] * (um2[i] * w0[i] + um1[i] * w1[i] + u * w2[i]); ss += y[i] * y[i]; um2[i] = um1[i]; um1[i] = u; }
            ss += __shfl_xor(ss, 1); ss += __shfl_xor(ss, 2); ss += __shfl_xor(ss, 4); ss += __shfl_xor(ss, 8);
            const float rstd = 1.0f / sqrtf(ss * (1.0f / 128.0f) + EPS);
            v4u o; o.x = cvtpk(y[0] * rstd * gg[0], y[1] * rstd * gg[1]); o.y = cvtpk(y[2] * rstd * gg[2], y[3] * rstd * gg[3]);
            o.z = cvtpk(y[4] * rstd * gg[4], y[5] * rstd * gg[5]); o.w = cvtpk(y[6] * rstd * gg[6], y[7] * rstd * gg[7]);
            *(GAS v4u*)(F.Y + (size_t)(row0 + t) * DM + ch) = o;
        }
    }
}

__device__ __forceinline__ void p4_gla_out(Frame& F) {
    LAS unsigned char* KDT = F.lds;
    LAS unsigned char* VT = F.lds + 18432;
    LAS unsigned char* QT = F.lds + 18432 + 33792;
    LAS float* DECS = (LAS float*)(F.lds + 69632);
    LAS float* RS = (LAS float*)(F.lds + 69632 + 512);
    const int tid = F.tid, lane = F.lane, w = F.wave, l31 = lane & 31, hh = lane >> 5;
    for (int uid = blockIdx.x; uid < 256; uid += F.G) {
        const int b = uid >> 7, r = (uid >> 2) & 31, h = uid & 3;
        const int row0 = b * SEQ + r * 256;
        f32x16 S[4];
        { const float* src = F.SSTART + ((size_t)uid * 8 + w) * 4096 + lane;
#pragma unroll
          for (int kb = 0; kb < 4; ++kb)
#pragma unroll
              for (int reg = 0; reg < 16; ++reg) S[kb][reg] = src[kb * 1024 + reg * 64]; }
        f32x4 gn[4];
#pragma unroll
        for (int g = 0; g < 4; ++g) gn[g] = *(const f32x4*)(F.gla_g + 32 * w + 8 * g + 4 * hh);
        for (int j = 0; j < 4; ++j) {
            const int rowc = row0 + j * 64, chunk = b * 128 + r * 4 + j;
            __syncthreads();
            { const GAS v4u* src = (const GAS v4u*)(F.KDECT + (size_t)(chunk * 4 + h) * 128 * 64);
              for (int i = tid; i < 1024; i += NWAVES * 64) { const int k = i >> 3, p = i & 7; *(LAS v4u*)(KDT + k * 144 + p * 16) = src[i]; } }
            for (int i = tid; i < 2048; i += NWAVES * 64) { const int t = i >> 5, c16 = i & 31;
                const v4u v = *(const GAS v4u*)(F.Z + (size_t)(rowc + t) * NZ + ZV + h * 256 + c16 * 8); *(LAS v4u*)(VT + t * 528 + c16 * 16) = v; }
            for (int i = tid; i < 1024; i += NWAVES * 64) { const int t = i >> 4, p = i & 15;
                const v4u v = *(const GAS v4u*)(F.Z + (size_t)(rowc + t) * NZ + ZQ + h * 128 + p * 8); *(LAS v4u*)(QT + t * 272 + p * 16) = v; }
            if (tid < 128) DECS[tid] = F.DEC[(size_t)chunk * 512 + h * 128 + tid];
            __syncthreads();
#pragma unroll
            for (int kb = 0; kb < 4; ++kb)
#pragma unroll
                for (int reg = 0; reg < 16; ++reg) S[kb][reg] *= DECS[32 * kb + crow(reg, hh)];
#pragma unroll
            for (int s = 0; s < 4; ++s) {
                bf16x8 bfrag;
#pragma unroll
                for (int jj = 0; jj < 8; ++jj) bfrag[jj] = *(const LAS short*)(VT + (16 * s + 8 * hh + jj) * 528 + (32 * w + l31) * 2);
#pragma unroll
                for (int kb = 0; kb < 4; ++kb) { const bf16x8 afrag = *(const LAS bf16x8*)(KDT + (32 * kb + l31) * 144 + (16 * s + 8 * hh) * 2); S[kb] = MFMA32(afrag, bfrag, S[kb]); }
            }
            bf16x8 Sb[4][2];
#pragma unroll
            for (int kb = 0; kb < 4; ++kb)
#pragma unroll
                for (int s = 0; s < 2; ++s) { v4u p; p.x = cvtpk(S[kb][8 * s + 0], S[kb][8 * s + 1]); p.y = cvtpk(S[kb][8 * s + 2], S[kb][8 * s + 3]); p.z = cvtpk(S[kb][8 * s + 4], S[kb][8 * s + 5]); p.w = cvtpk(S[kb][8 * s + 6], S[kb][8 * s + 7]);
                    Sb[kb][s] = __builtin_bit_cast(bf16x8, p); }
            f32x16 oT[2];
#pragma unroll
            for (int tb = 0; tb < 2; ++tb) {
#pragma unroll
                for (int reg = 0; reg < 16; ++reg) oT[tb][reg] = 0.f;
#pragma unroll
                for (int kb = 0; kb < 4; ++kb)
#pragma unroll
                    for (int s = 0; s < 2; ++s) { const LAS unsigned char* qp = QT + (32 * tb + l31) * 272 + (32 * kb + 16 * s + 4 * hh) * 2;
                        const bf16x4 lo = *(const LAS bf16x4*)qp, hi = *(const LAS bf16x4*)(qp + 16);
                        const bf16x8 pb = __builtin_shufflevector(lo, hi, 0, 1, 2, 3, 4, 5, 6, 7);
                        oT[tb] = MFMA32(Sb[kb][s], pb, oT[tb]); }
            }
#pragma unroll
            for (int tb = 0; tb < 2; ++tb) { float ss = 0.f;
#pragma unroll
                for (int reg = 0; reg < 16; ++reg) { oT[tb][reg] *= QSCALE; ss += oT[tb][reg] * oT[tb][reg]; }
                ss += __shfl_xor(ss, 32);
                if (hh == 0) RS[(32 * tb + l31) * 8 + w] = ss; }
            __syncthreads();
#pragma unroll
            for (int tb = 0; tb < 2; ++tb) { const int t = 32 * tb + l31;
                const LAS f32x4* rp = (const LAS f32x4*)(RS + t * 8); const f32x4 r0 = rp[0], r1 = rp[1];
                const float tot = ((r0[0] + r0[1]) + (r0[2] + r0[3])) + ((r1[0] + r1[1]) + (r1[2] + r1[3]));
                const float rstd = 1.0f / sqrtf(tot * (1.0f / 256.0f) + EPS);
                const bf16* ogp = F.Z + (size_t)(rowc + t) * NZ + ZOG + h * 256 + 32 * w + 4 * hh;
                bf16* yp = F.Y + (size_t)(rowc + t) * DM + 1024 + h * 256 + 32 * w + 4 * hh;
#pragma unroll
                for (int g = 0; g < 4; ++g) { const v2u og2 = *(const GAS v2u*)(ogp + 8 * g);
                    const float og0 = bflo(og2.x), og1 = bfhi(og2.x), og2f = bflo(og2.y), og3 = bfhi(og2.y);
                    const float y0 = oT[tb][4 * g + 0] * rstd * gn[g][0] * (og0 / (1.f + __expf(-og0)));
                    const float y1 = oT[tb][4 * g + 1] * rstd * gn[g][1] * (og1 / (1.f + __expf(-og1)));
                    const float y2 = oT[tb][4 * g + 2] * rstd * gn[g][2] * (og2f / (1.f + __expf(-og2f)));
                    const float y3 = oT[tb][4 * g + 3] * rstd * gn[g][3] * (og3 / (1.f + __expf(-og3)));
                    v2u o; o.x = cvtpk(y0, y1); o.y = cvtpk(y2, y3); *(GAS v2u*)(yp + 8 * g) = o; } }
        }
    }
}

__device__ __forceinline__ void p8_final_norm(Frame& F) {
    const int gw = F.vcu * NWAVES + F.wave, NGW = F.G * NWAVES;
    f32x4 gv[8];
#pragma unroll
    for (int j = 0; j < 8; ++j) gv[j] = *(const f32x4*)(F.gf + 4 * F.lane + 256 * j);
    for (int m = gw; m < M; m += NGW) {
        const float rstd = 1.0f / sqrtf(F.ROWSQ2[m] * (1.0f / DM) + EPS);
        GAS f32x4* o = (GAS f32x4*)(F.out + (size_t)m * DM) + F.lane;
        f32x4 v[8];
#pragma unroll
        for (int j = 0; j < 8; ++j) v[j] = o[64 * j];
#pragma unroll
        for (int j = 0; j < 8; ++j) o[64 * j] = v[j] * rstd * gv[j];
    }
}

struct Args { const float* in[13]; float* out; unsigned char* ws; int ph_lo, ph_hi, li, pad; };
__global__ void __launch_bounds__(NWAVES * 64, 2) skel_fwd(Args args) {
    extern __shared__ __attribute__((aligned(16))) unsigned char lds[];
    Frame F;
    F.lds = (LAS unsigned char*)lds;
    F.MISC = (volatile LAS unsigned*)(F.lds + MISC_OFF);
    F.tid = threadIdx.x; F.lane = F.tid & 63; F.wave = __builtin_amdgcn_readfirstlane(F.tid >> 6);
    F.G = gridDim.x; { const int bx = blockIdx.x; F.vcu = (F.G % 8 == 0) ? (bx % 8) * (F.G / 8) + bx / 8 : bx; }
    unsigned char* ws = args.ws;
    F.ctl = (gu32*)(ws + WS_CTL);
    F.x = args.in[0]; F.g1 = args.in[1]; F.w_in = args.in[2]; F.wgate = args.in[3]; F.bgate = args.in[4]; F.conv_w = args.in[5]; F.conv_g = args.in[6];
    F.gla_g = args.in[7]; F.w_out = args.in[8]; F.g2 = args.in[9]; F.w1 = args.in[10]; F.w2 = args.in[11]; F.gf = args.in[12]; F.out = args.out;
    F.WIN_T = (bf16*)(ws + WS_WIN); F.WOUT_T = (bf16*)(ws + WS_WOUT); F.W1_T = (bf16*)(ws + WS_W1); F.W2_T = (bf16*)(ws + WS_W2);
    F.XN = (bf16*)(ws + WS_XN); F.Z = (bf16*)(ws + WS_Z); F.Y = (bf16*)(ws + WS_Y); F.H = (bf16*)(ws + WS_H); F.KDECT = (bf16*)(ws + WS_KDECT);
    F.ALOW = (float*)(ws + WS_ALOW); F.RSTD1 = (float*)(ws + WS_RSTD1); F.DEC = (float*)(ws + WS_DEC); F.DRUN = (float*)(ws + WS_DRUN);
    F.RUNAGG = (float*)(ws + WS_RUNAGG); F.SSTART = (float*)(ws + WS_SSTART);
    F.ROWSQ1 = (float*)(ws + WS_CTL) + CW_ROWSQ1; F.ROWSQ2 = (float*)(ws + WS_CTL) + CW_ROWSQ2;
    for (int u = F.tid; u < (LDS_BYTES - LDSCTL_OFF) / 4; u += NWAVES * 64) ((LAS unsigned*)(F.lds + LDSCTL_OFF))[u] = 0u;
    __syncthreads();
    XcdBarrier bar; bar.bar = (unsigned*)(F.ctl + CW_BAR); bar.x = 0; bar.st = nullptr;
    if (N_LAUNCHES == 1) bar = xcd_barrier_post((unsigned*)(F.ctl + CW_BAR), F.MISC + 8);
#define GRID_BAR() do { if (N_LAUNCHES == 1) { xcd_barrier(bar); } } while (0)
    const int lo = args.ph_lo, hi = args.ph_hi;
#if defined(PROBE_A)
    unsigned long long t_prev = __builtin_amdgcn_s_memrealtime(), d_a = 0ull; const unsigned long long t_entry = t_prev;
#define STAMP(k) do { const unsigned long long now_ = __builtin_amdgcn_s_memrealtime(); if ((k) == PROBE_A) d_a = now_ - t_prev; t_prev = now_; } while (0)
#else
#define STAMP(k) do { } while (0)
#endif
#define IN(k) (lo <= (k) && (k) < hi)
#define BOTH(k) (IN(k) && IN((k) + 1))

    if (IN(0)) { p0_prologue(F); if (BOTH(0)) GRID_BAR(); STAMP(0); }

    if (IN(1)) {
        pg8::Gemm g{F.XN, F.WIN_T, M, NZ, DM}; pg8::StaticOrder S; S.init(M, NZ, F.G, (int)blockIdx.x);
        pg8::EpiBf16Row<0, 0> E{F.Z, NZ, F.RSTD1, 0.f, 0.f};
        pg8::gemm_phase<pg8::EpiBf16Row<0, 0>, pg8::StaticOrder, PG8_ALIGN, PG8_SP2>(F.lds + RING_OFF, g, S, E);
        if (BOTH(1)) GRID_BAR(); STAMP(1);
    }
    if (IN(2)) { p2_gate_runagg(F); if (BOTH(2)) GRID_BAR(); STAMP(2); }
    if (IN(3)) { p3_scan(F); p3_conv(F); if (BOTH(3)) GRID_BAR(); STAMP(3); }
    if (IN(4)) { p4_gla_out(F); if (BOTH(4)) GRID_BAR(); STAMP(4); }
    if (IN(5)) {
        pg8::Gemm g{F.Y, F.WOUT_T, M, DM, DM}; pg8::StaticOrder S; S.init(M, DM, F.G, (int)blockIdx.x);
        pg8::EpiRes1 E{F.x, F.XN, F.g2, F.ROWSQ1, DM};
        pg8::gemm_phase<pg8::EpiRes1, pg8::StaticOrder, PG8_ALIGN, PG8_SP2>(F.lds + RING_OFF, g, S, E);
        if (BOTH(5)) GRID_BAR(); STAMP(5);
    }
    if (IN(6)) {
        pg8::Gemm g{F.XN, F.W1_T, M, FF, DM}; pg8::StaticOrder S; S.init(M, FF, F.G, (int)blockIdx.x);
        pg8::EpiBf16Row<1, 1> E{F.H, FF, F.ROWSQ1, 1.0f / DM, EPS};
        pg8::gemm_phase<pg8::EpiBf16Row<1, 1>, pg8::StaticOrder, PG8_ALIGN, PG8_SP2>(F.lds + RING_OFF, g, S, E);
        if (BOTH(6)) GRID_BAR(); STAMP(6);
    }
    if (IN(7)) {
        pg8::Gemm g{F.H, F.W2_T, M, DM, FF}; pg8::StaticOrder S; S.init(M, DM, F.G, (int)blockIdx.x);
        pg8::EpiRes2 E{F.XN, F.g2, F.out, F.ROWSQ2, DM};
        pg8::gemm_phase<pg8::EpiRes2, pg8::StaticOrder, PG8_ALIGN, PG8_SP2>(F.lds + RING_OFF, g, S, E);
        if (BOTH(7)) GRID_BAR(); STAMP(7);
    }
    if (IN(8)) { p8_final_norm(F); }
#if defined(PROBE_A)
    if (PROBE_A == 8) { asm volatile("s_waitcnt vmcnt(0)" ::: "memory"); __syncthreads(); STAMP(8); }
    if (PROBE_A == 9) { GRID_BAR(); d_a = __builtin_amdgcn_s_memrealtime() - t_entry; }
    if (blockIdx.x == 0) { asm volatile("s_waitcnt vmcnt(0)" ::: "memory"); __syncthreads();
        if (F.tid == 0) F.out[0] += (0.01f / (float)(PROBE_SCALE)) * (float)d_a; }
#endif
#undef IN
#undef BOTH
}

extern "C" void kernel_launch(void* const* d_in, const int* in_sizes, int n_in, void* d_out, int out_size, void* d_ws, size_t ws_size, hipStream_t stream) {
    static int grid = 0;
    if (grid == 0) {
        if (n_in != 13 || in_sizes[0] != M * DM || out_size != M * DM || ws_size < WS_END) { fprintf(stderr, "kernel_launch: built for 13 inputs, x and out of %d floats, >= %zu bytes of workspace; got n_in %d, in0 %d, out %d, ws %zu; nothing launched\n", M * DM, (size_t)WS_END, n_in, n_in > 0 ? in_sizes[0] : -1, out_size, ws_size); grid = -1; return; }
        int dev = 0, cus = 0, per_cu = 0;
        if (hipGetDevice(&dev) != hipSuccess || hipDeviceGetAttribute(&cus, hipDeviceAttributeMultiprocessorCount, dev) != hipSuccess) { fprintf(stderr, "kernel_launch: hipGetDevice / hipDeviceGetAttribute failed; nothing launched\n"); grid = -1; return; }
        if (hipFuncSetAttribute((const void*)skel_fwd, hipFuncAttributeMaxDynamicSharedMemorySize, LDS_BYTES) != hipSuccess) { fprintf(stderr, "kernel_launch: hipFuncSetAttribute failed; nothing launched\n"); grid = -1; return; }
        if (hipOccupancyMaxActiveBlocksPerMultiprocessor(&per_cu, (const void*)skel_fwd, NWAVES * 64, LDS_BYTES) != hipSuccess || per_cu < 1)
            fprintf(stderr, "kernel_launch: note: the occupancy query reports %d workgroups per CU\n", per_cu);
        (void)hipGetLastError();
        grid = cus;
    }
    if (grid < 0) return;
    if (hipMemsetAsync((char*)d_ws + WS_CTL, 0, CTL_ZERO_BYTES, stream) != hipSuccess) { fprintf(stderr, "kernel_launch: hipMemsetAsync of the control words failed; nothing launched\n"); return; }
    Args a{};
    for (int i = 0; i < 13; ++i) a.in[i] = (const float*)d_in[i];
    a.out = (float*)d_out; a.ws = (unsigned char*)d_ws;
    for (int li = 0; li < N_LAUNCHES; ++li) {
        a.ph_lo = (N_LAUNCHES == 1) ? 0 : li; a.ph_hi = (N_LAUNCHES == 1) ? N_PHASES : li + 1; a.li = li;
        hipLaunchKernelGGL(skel_fwd, dim3(grid), dim3(NWAVES * 64), LDS_BYTES, stream, a);
        const hipError_t le = hipPeekAtLastError();
        if (le != hipSuccess) { fprintf(stderr, "kernel_launch: launch %d failed: %s\n", li, hipGetErrorName(le)); break; }
    }
}
```
